# Optimizing an MI355X kernel written in HIP

```python
import jax, jax.numpy as jnp
from jax import lax
import numpy as np

D_MODEL = 1024
BATCH = 8
SEQ = 4096
DEPTH = 2

N_EVEN = (DEPTH + 1) // 2
N_ODD = DEPTH // 2

HEAD_DIM = 64
N_HEADS = D_MODEL // HEAD_DIM
N_KV_HEADS = 4
GROUP = N_HEADS // N_KV_HEADS
Q_WIDTH = N_HEADS * HEAD_DIM
KV_WIDTH = N_KV_HEADS * HEAD_DIM
QKV_WIDTH = Q_WIDTH + 2 * KV_WIDTH
WINDOW = 128
BLOCK = 128
NEG_INF = -1e30

POOL_WINDOWS = (2, 4, 8, 16)
N_POOL_GROUPS = len(POOL_WINDOWS)
POOL_GROUP_DIM = D_MODEL // N_POOL_GROUPS

D_FF = 2816
N_EXPERTS = 8
TOP_K = 2
D_FF_EXPERT = 3584

RMS_EPS = 1e-5

kernel_name = "hybrid_swa_sink_alibi_pool_moe_trunk"


def rms_norm(x, gain):
    xf = x.astype(jnp.float32)
    y = xf * lax.rsqrt(jnp.mean(xf * xf, axis=-1, keepdims=True) + RMS_EPS)
    return (y * gain.astype(jnp.float32)).astype(x.dtype)


def alibi_slopes(n_heads):
    return jnp.exp2(-8.0 * jnp.arange(1, n_heads + 1, dtype=jnp.float32) / n_heads)


def swiglu(h, w_gate, w_up, w_down):
    return (jax.nn.silu(h @ w_gate) * (h @ w_up)) @ w_down


def sliding_window_attention(h, w_qkv, sinks, w_o):
    B, S, _ = h.shape
    nb = S // BLOCK
    qkv = h @ w_qkv
    q, k, v = jnp.split(qkv, [Q_WIDTH, Q_WIDTH + KV_WIDTH], axis=-1)
    q = q.reshape(B, nb, BLOCK, N_KV_HEADS, GROUP, HEAD_DIM)
    k = k.reshape(B, nb, BLOCK, N_KV_HEADS, HEAD_DIM)
    v = v.reshape(B, nb, BLOCK, N_KV_HEADS, HEAD_DIM)

    def with_prev(t):
        prev = jnp.pad(t[:, :-1], ((0, 0), (1, 0), (0, 0), (0, 0), (0, 0)))
        return jnp.concatenate([prev, t], axis=2)

    kb, vb = with_prev(k), with_prev(v)
    s = jnp.einsum('bnqhgd,bnkhd->bhgnqk', q, kb,
                   preferred_element_type=jnp.float32) * (HEAD_DIM ** -0.5)

    blk = jnp.arange(nb)[:, None, None] * BLOCK
    q_pos = blk + jnp.arange(BLOCK)[None, :, None]
    k_pos = blk - BLOCK + jnp.arange(2 * BLOCK)[None, None, :]
    dist = q_pos - k_pos
    valid = (dist >= 0) & (dist < WINDOW) & (k_pos >= 0)
    slopes = alibi_slopes(N_HEADS).reshape(N_KV_HEADS, GROUP)
    bias = -slopes[:, :, None, None, None] * dist.astype(jnp.float32)[None, None]
    s = jnp.where(valid[None, None, None], s + bias[None], NEG_INF)

    sink = jnp.broadcast_to(sinks.astype(jnp.float32).reshape(1, N_KV_HEADS, GROUP, 1, 1, 1),
                            s.shape[:-1] + (1,))
    p = jax.nn.softmax(jnp.concatenate([s, sink], axis=-1), axis=-1)[..., :-1]
    o = jnp.einsum('bhgnqk,bnkhd->bnqhgd', p.astype(vb.dtype), vb)
    return o.reshape(B, S, Q_WIDTH) @ w_o


def pooling_mixer(h, w_pool, scale):
    B, S, D = h.shape
    groups = jnp.split(h, N_POOL_GROUPS, axis=-1)
    count = jnp.arange(1, S + 1, dtype=jnp.float32)[None, :, None]
    outs = []
    for g, w in zip(groups, POOL_WINDOWS):
        gf = g.astype(jnp.float32)
        c = lax.cumsum(gf, axis=1)
        lower = jnp.pad(c[:, :S - w], ((0, 0), (w, 0), (0, 0)))
        mean = (c - lower) / jnp.minimum(count, float(w))
        outs.append((mean - gf).astype(h.dtype))
    p = jnp.stack(outs, axis=2)
    y = jnp.einsum('bsgc,gcd->bsgd', p, w_pool).reshape(B, S, D)
    return y * scale


def moe_swiglu(h, w_router, w_gate, w_up, w_down):
    B, S, D = h.shape
    t = h.reshape(B * S, D)
    logits = jnp.dot(t, w_router, preferred_element_type=jnp.float32)
    top_val, top_idx = lax.top_k(logits, TOP_K)
    gates = jax.nn.softmax(top_val, axis=-1)
    combine = jnp.sum(jax.nn.one_hot(top_idx, N_EXPERTS, dtype=jnp.float32)
                      * gates[..., None], axis=1).astype(t.dtype)
    out = jnp.zeros_like(t)
    for e in range(N_EXPERTS):
        out = out + combine[:, e:e + 1] * swiglu(t, w_gate[e], w_up[e], w_down[e])
    return out.reshape(B, S, D)


def setup_inputs(seed: int = 0) -> dict:
    key = jax.random.key(seed)
    ks = jax.random.split(key, 24)
    f32 = jnp.float32
    nrm = lambda k, shape, scale: jax.random.normal(k, shape, f32) * scale
    gain = lambda k, shape: 1.0 + 0.05 * jax.random.normal(k, shape, f32)
    return {
        "x": jax.random.normal(ks[0], (BATCH, SEQ, D_MODEL), f32),
        "attn_norm": gain(ks[1], (N_EVEN, D_MODEL)),
        "attn_w_qkv": nrm(ks[2], (N_EVEN, D_MODEL, QKV_WIDTH), D_MODEL ** -0.5),
        "attn_sinks": nrm(ks[3], (N_EVEN, N_HEADS), 0.5),
        "attn_w_o": nrm(ks[4], (N_EVEN, Q_WIDTH, D_MODEL), Q_WIDTH ** -0.5),
        "ffn_norm": gain(ks[5], (N_EVEN, D_MODEL)),
        "ffn_w_gate": nrm(ks[6], (N_EVEN, D_MODEL, D_FF), D_MODEL ** -0.5),
        "ffn_w_up": nrm(ks[7], (N_EVEN, D_MODEL, D_FF), D_MODEL ** -0.5),
        "ffn_w_down": nrm(ks[8], (N_EVEN, D_FF, D_MODEL), D_FF ** -0.5),
        "pool_norm": gain(ks[9], (N_ODD, D_MODEL)),
        "pool_w": nrm(ks[10], (N_ODD, N_POOL_GROUPS, POOL_GROUP_DIM, POOL_GROUP_DIM), POOL_GROUP_DIM ** -0.5),
        "pool_scale": gain(ks[11], (N_ODD, D_MODEL)),
        "moe_norm": gain(ks[12], (N_ODD, D_MODEL)),
        "moe_w_router": nrm(ks[13], (N_ODD, D_MODEL, N_EXPERTS), D_MODEL ** -0.5),
        "moe_w_gate": nrm(ks[14], (N_ODD, N_EXPERTS, D_MODEL, D_FF_EXPERT), D_MODEL ** -0.5),
        "moe_w_up": nrm(ks[15], (N_ODD, N_EXPERTS, D_MODEL, D_FF_EXPERT), D_MODEL ** -0.5),
        "moe_w_down": nrm(ks[16], (N_ODD, N_EXPERTS, D_FF_EXPERT, D_MODEL), D_FF_EXPERT ** -0.5),
        "final_norm": gain(ks[17], (D_MODEL,)),
    }


def reference(x, attn_norm, attn_w_qkv, attn_sinks, attn_w_o,
              ffn_norm, ffn_w_gate, ffn_w_up, ffn_w_down,
              pool_norm, pool_w, pool_scale,
              moe_norm, moe_w_router, moe_w_gate, moe_w_up, moe_w_down,
              final_norm):
    for i in range(DEPTH):
        j = i // 2
        if i % 2 == 0:
            x = x + sliding_window_attention(rms_norm(x, attn_norm[j]), attn_w_qkv[j],
                                             attn_sinks[j], attn_w_o[j])
            x = x + swiglu(rms_norm(x, ffn_norm[j]), ffn_w_gate[j], ffn_w_up[j], ffn_w_down[j])
        else:
            x = x + pooling_mixer(rms_norm(x, pool_norm[j]), pool_w[j], pool_scale[j])
            x = x + moe_swiglu(rms_norm(x, moe_norm[j]), moe_w_router[j],
                               moe_w_gate[j], moe_w_up[j], moe_w_down[j])
    return rms_norm(x, final_norm)
```

```cpp
#include <hip/hip_runtime.h>
#include <cstdio>
#include <cstdint>

#ifndef MK_PER_PHASE
#define MK_PER_PHASE 0
#endif

#define LAS __attribute__((address_space(3)))
#define GAS __attribute__((address_space(1)))
typedef unsigned short bf16_t;
typedef short bf16x8 __attribute__((ext_vector_type(8)));
typedef short s16x4 __attribute__((ext_vector_type(4)));
typedef float f32x4 __attribute__((ext_vector_type(4)));
typedef float f32x2 __attribute__((ext_vector_type(2)));
typedef float f32x16 __attribute__((ext_vector_type(16)));
typedef unsigned u32x4 __attribute__((ext_vector_type(4)));
typedef unsigned u32x2 __attribute__((ext_vector_type(2)));
typedef __bf16 bf16v2 __attribute__((ext_vector_type(2)));

constexpr int BATCH = 8, SEQ = 4096, T = BATCH * SEQ, D = 1024, QKVW = 1536, DFF = 2816, NE = 8, DFE = 3584, NHEAD = 16, NKV = 4, HD = 64;
constexpr float RMS_EPS = 1e-5f, LOG2E = 1.4426950408889634f;
constexpr float QSCALE = 0.125f * LOG2E;
constexpr int NPASS = 5, TPMAX = 53, GMAX = 264;

constexpr size_t MiB = 1u << 20;
constexpr size_t WS_CTL = 0, CTL_ZERO_BYTES = 1 * MiB;
constexpr size_t WS_LIST = 1 * MiB;
constexpr size_t WS_GSORT = 2 * MiB;
constexpr size_t WS_TOKINFO = 3 * MiB;
constexpr size_t WS_WQKV = 4 * MiB;
constexpr size_t WS_WO = 7 * MiB;
constexpr size_t WS_WGU = 9 * MiB;
constexpr size_t WS_WD = 20 * MiB;
constexpr size_t WS_WP = 26 * MiB;
constexpr size_t WS_MGU = 27 * MiB;
constexpr size_t WS_MD = 139 * MiB;
constexpr size_t WS_HB = 195 * MiB;
constexpr size_t WS_B = 259 * MiB;
constexpr size_t WS_Y = WS_B, WS_MACT = WS_B + 132 * MiB;
constexpr size_t WS_END = WS_MACT + (size_t)TPMAX * 256 * DFE * 2;
static_assert(WS_END <= 512 * MiB, "workspace");
static_assert((size_t)GMAX * 256 * D * 2 <= 132 * MiB, "y");
static_assert(WS_MGU + (size_t)NE * 2 * DFE * D * 2 <= WS_MD && WS_MD + (size_t)NE * D * DFE * 2 <= WS_HB && WS_HB + (size_t)T * D * 2 <= WS_B, "map");
static_assert(WS_B + (size_t)T * DFF * 2 <= 512 * MiB, "act");
constexpr int CW_TMO = 0;
constexpr int CW_BAR = 4096;
constexpr int CW_CNT = 16384;

constexpr int RING_BYTES = 131072;
constexpr int LDS_BYTES = 147456;
constexpr int MISC_OFF = 146432;

#define RLX_AGENT __ATOMIC_RELAXED, __HIP_MEMORY_SCOPE_AGENT
#define LDS_WAIT() asm volatile("s_waitcnt lgkmcnt(0)" ::: "memory")
#define VM_WAIT() asm volatile("s_waitcnt vmcnt(0)" ::: "memory")

__device__ __forceinline__ unsigned pk2(float lo, float hi) { bf16v2 v = {(__bf16)lo, (__bf16)hi}; return __builtin_bit_cast(unsigned, v); }
__device__ __forceinline__ float wave_sum(float v) {
#pragma unroll
    for (int o = 1; o < 64; o <<= 1) v += __shfl_xor(v, o);
    return v;
}

#define XB_TMO      128
#define XB_XCNT(j)  (256  + 64 * (j))
#define XB_XSUB(j)  (1280 + 64 * (j))
#define XB_XGEN(j)  (2304 + 64 * (j))
#define XB_TOP      3328
#define XB_TOPGEN   3392
#define XCD_BAR_WORDS 3456
#define XB_SPIN_CAP (1u << 18)
__device__ __forceinline__ unsigned xb_ld(unsigned* p)              { return __hip_atomic_load(p, __ATOMIC_RELAXED, __HIP_MEMORY_SCOPE_AGENT); }
__device__ __forceinline__ unsigned xb_add(unsigned* p, unsigned v) { return __hip_atomic_fetch_add(p, v, __ATOMIC_RELAXED, __HIP_MEMORY_SCOPE_AGENT); }
__device__ __forceinline__ unsigned xb_xcc_id() { return (unsigned)__builtin_amdgcn_s_getreg((3 << 11) | 20) & 0xFu; }
#define XB_SPIN(cond, bar) do { unsigned _sp = 0; while (cond) { __builtin_amdgcn_s_sleep(1); \
    if ((++_sp & 255u) == 0u) { if (xb_ld(&(bar)[XB_TMO])) break; if (_sp > XB_SPIN_CAP) { atomicAdd(&(bar)[XB_TMO], 1u); break; } } } } while (0)
struct XcdBarrier { unsigned* bar; unsigned x; volatile LAS unsigned* st; };
__device__ __forceinline__ XcdBarrier xcd_barrier_post(unsigned* bar, volatile LAS unsigned* st) {
    XcdBarrier b; b.bar = bar; b.x = xb_xcc_id(); b.st = st;
    if (threadIdx.x == 0) (void)xb_add(&bar[XB_XCNT(b.x)], 1u);
    return b;
}
__device__ __forceinline__ void xcd_barrier_complete(unsigned* bar, unsigned x, unsigned& nloc, unsigned& nx) {
    const unsigned G = gridDim.x * gridDim.y * gridDim.z;
    unsigned sum, cnt, mine, sp = 0u;
    for (;;) {
        sum = 0u; cnt = 0u; mine = 0u;
#pragma unroll
        for (unsigned j = 0; j < 16; ++j) { const unsigned c = xb_ld(&bar[XB_XCNT(j)]); sum += c; cnt += (c > 0u) ? 1u : 0u; mine = (j == x) ? c : mine; }
        if (sum == G) break;
        __builtin_amdgcn_s_sleep(1);
        if ((++sp & 255u) == 0u) { if (xb_ld(&bar[XB_TMO])) break; if (sp > XB_SPIN_CAP) { atomicAdd(&bar[XB_TMO], 1u); break; } }
    }
    nloc = mine > 0u ? mine : 1u; nx = cnt > 0u ? cnt : 1u;
}
__device__ __forceinline__ void xcd_barrier(const XcdBarrier& b) {
    asm volatile("s_waitcnt vmcnt(0)" ::: "memory");
    __syncthreads();
    if (threadIdx.x == 0) {
        unsigned* bar = b.bar;
        __builtin_amdgcn_s_waitcnt(0);
        unsigned nloc = b.st[0], nx = b.st[1];
        if (nloc == 0u) { xcd_barrier_complete(bar, b.x, nloc, nx); b.st[0] = nloc; b.st[1] = nx; }
        const unsigned old = xb_add(&bar[XB_XSUB(b.x)], 1u);
        const unsigned gen = old / nloc;
        if (old + 1u == (gen + 1u) * nloc) {
            __builtin_amdgcn_fence(__ATOMIC_RELEASE, "agent");
            asm volatile("s_waitcnt vmcnt(0)" ::: "memory");
            const unsigned og = xb_add(&bar[XB_TOP], 1u);
            const unsigned tg = og / nx;
            if (og + 1u == (tg + 1u) * nx) xb_add(&bar[XB_TOPGEN], 1u);
            else XB_SPIN(xb_ld(&bar[XB_TOPGEN]) == tg, bar);
            __builtin_amdgcn_fence(__ATOMIC_ACQUIRE, "agent");
            xb_add(&bar[XB_XGEN(b.x)], 1u);
            asm volatile("s_waitcnt vmcnt(0)" ::: "memory");
        } else {
            XB_SPIN(xb_ld(&bar[XB_XGEN(b.x)]) == gen, bar);
            __builtin_amdgcn_fence(__ATOMIC_ACQUIRE, "agent");
            asm volatile("s_waitcnt vmcnt(0)" ::: "memory");
        }
    }
    __syncthreads();
}

namespace pg8 {
constexpr int BM = 256, BK = 64, HALF = 128, HTB = HALF * BK * 2, NXCD = 8, WGM = 8;
__device__ __forceinline__ int lds_byte(int r, int c) { const int st = (r >> 4) * 2 + (c >> 5), rr = r & 15, cc = c & 31, ob = rr * 64 + cc * 2; return st * 1024 + (ob ^ (((ob >> 9) & 1) << 5)); }
__device__ __forceinline__ void stage_rc(int b, int& R, int& C) { const int st = b / 1024, sb = b % 1024, swz = sb ^ (((sb >> 9) & 1) << 5); R = (st >> 1) * 16 + swz / 64; C = (st & 1) * 32 + (swz % 64) / 2; }
__device__ __forceinline__ int perm32(int rho) { const int n = rho >> 4, i = rho & 15; return 8 * (i >> 2) + 4 * n + (i & 3); }

struct Unit { int pm, pn, e; };

__device__ __forceinline__ bool tile_of(int i, int G, int c, int nM, int nN, int& pm, int& pn) {
    const int nwg = nM * nN; const long L = (long)i * G + c; if (L >= nwg) return false;
    int wgid = (int)L; { const int q = nwg / NXCD, r = nwg % NXCD, xcd = wgid % NXCD, off = wgid / NXCD; wgid = (xcd < r ? xcd * (q + 1) : r * (q + 1) + (xcd - r) * q) + off; }
    const int nig = WGM * nN, gid = wgid / nig, fm = gid * WGM, gsz = (nM - fm) < WGM ? (nM - fm) : WGM;
    pm = fm + ((wgid % nig) % gsz); pn = (wgid % nig) / gsz; return true;
}
struct DenseOrder {
    const bf16_t* A; const bf16_t* Bt; int lda, ldb, nM, nN, G, c; int grouped;
    __device__ __forceinline__ bool next(int i, Unit& u) const { u.e = 0; return tile_of(i, G, c, nM, nN, u.pm, u.pn); }
    __device__ __forceinline__ const char* a_base(const Unit& u) const { return (const char*)(A + (size_t)u.pm * 256 * lda + (grouped ? u.pn * 256 : 0)); }
    __device__ __forceinline__ const char* b_base(const Unit& u) const { return (const char*)(Bt + (size_t)u.pn * 256 * ldb); }
    __device__ __forceinline__ int grow(const Unit&, int) const { return 0; }
};
struct MoeOrder {
    const bf16_t* A; const bf16_t* Bt; int lda, ldb, nM, nN, G, c, t0; size_t bstride;
    const volatile LAS int* tb; const int* list; int gather;
    __device__ __forceinline__ bool next(int i, Unit& u) const {
        if (!tile_of(i, G, c, nM, nN, u.pm, u.pn)) return false;
        u.pm += t0; int e = 0;
#pragma unroll
        for (int j = 1; j < 8; ++j) e += (u.pm >= tb[j]) ? 1 : 0;
        u.e = e; return true;
    }
    __device__ __forceinline__ const char* a_base(const Unit& u) const { return gather ? (const char*)A : (const char*)(A + (size_t)(u.pm - t0) * 256 * lda); }
    __device__ __forceinline__ const char* b_base(const Unit& u) const { return (const char*)(Bt + (size_t)u.e * bstride + (size_t)u.pn * 256 * ldb); }
    __device__ __forceinline__ int grow(const Unit& u, int r) const {
        const int p = (u.pm - tb[u.e]) * 256 + r, n = tb[16 + u.e];
        return p < n ? list[u.e * T + p] : 0;
    }
};

struct EpiQKV {
    static constexpr bool PERM = true;
    bf16_t* O;
    __device__ __forceinline__ void operator()(const f32x4 (&acc)[2][2][4][2], const Unit& u, int wr, int wc, int fr, int fq) const {
        const int row0 = u.pm * BM + wr * 64 + fr, col0 = u.pn * BM + wc * 32 + 8 * fq; const float sc = (u.pn < 4) ? QSCALE : 1.0f;
#pragma unroll
        for (int ai = 0; ai < 2; ++ai)
#pragma unroll
            for (int m = 0; m < 4; ++m) { bf16_t* rowp = O + (size_t)(row0 + ai * HALF + m * 16) * QKVW + col0;
#pragma unroll
                for (int bj = 0; bj < 2; ++bj) { const f32x4 v0 = acc[ai][bj][m][0] * sc, v1 = acc[ai][bj][m][1] * sc;
                    u32x4 w; w.x = pk2(v0[0], v0[1]); w.y = pk2(v0[2], v0[3]); w.z = pk2(v1[0], v1[1]); w.w = pk2(v1[2], v1[3]);
                    *(u32x4*)(rowp + bj * HALF) = w; } }
    }
};
struct EpiResF32 {
    static constexpr bool PERM = false;
    const float* res; float* out; const float* scale;
    __device__ __forceinline__ void operator()(const f32x4 (&acc)[2][2][4][2], const Unit& u, int wr, int wc, int fr, int fq) const {
        const int row0 = u.pm * BM + wr * 64 + fr, col0 = u.pn * BM + wc * 32 + 4 * fq;
#pragma unroll
        for (int bj = 0; bj < 2; ++bj)
#pragma unroll
            for (int n = 0; n < 2; ++n) { const f32x4 sv = scale ? *(const f32x4*)(scale + col0 + bj * HALF + n * 16) : (f32x4){1.f, 1.f, 1.f, 1.f};
#pragma unroll
                for (int ai = 0; ai < 2; ++ai) {
#pragma unroll
                    for (int m = 0; m < 4; ++m) { const size_t off = (size_t)(row0 + ai * HALF + m * 16) * D + col0 + bj * HALF + n * 16;
                        const f32x4 r = *(const f32x4*)(res + off); *(f32x4*)(out + off) = r + acc[ai][bj][m][n] * sv; }
                    asm volatile("" ::: "memory"); } }
    }
};
__device__ __forceinline__ float silu_mul(float g, float u) { return g * u * __builtin_amdgcn_rcpf(1.0f + __builtin_amdgcn_exp2f(-g * LOG2E)); }
struct EpiSwiGLU {
    static constexpr bool PERM = true;
    bf16_t* O; int ldc, tile0;
    __device__ __forceinline__ void operator()(const f32x4 (&acc)[2][2][4][2], const Unit& u, int wr, int wc, int fr, int fq) const {
        const int row0 = (u.pm - tile0) * BM + wr * 64 + fr, col0 = u.pn * HALF + wc * 32 + 8 * fq;
#pragma unroll
        for (int ai = 0; ai < 2; ++ai)
#pragma unroll
            for (int m = 0; m < 4; ++m) { bf16_t* rowp = O + (size_t)(row0 + ai * HALF + m * 16) * ldc + col0;
                const f32x4 g0 = acc[ai][0][m][0], g1 = acc[ai][0][m][1], u0 = acc[ai][1][m][0], u1 = acc[ai][1][m][1];
                u32x4 w; w.x = pk2(silu_mul(g0[0], u0[0]), silu_mul(g0[1], u0[1])); w.y = pk2(silu_mul(g0[2], u0[2]), silu_mul(g0[3], u0[3]));
                w.z = pk2(silu_mul(g1[0], u1[0]), silu_mul(g1[1], u1[1])); w.w = pk2(silu_mul(g1[2], u1[2]), silu_mul(g1[3], u1[3]));
                *(u32x4*)rowp = w; }
    }
};
struct EpiMoeDown {
    static constexpr bool PERM = true;
    bf16_t* Y; const float* gsort; const volatile LAS int* tb;
    __device__ __forceinline__ void operator()(const f32x4 (&acc)[2][2][4][2], const Unit& u, int wr, int wc, int fr, int fq) const {
        const int lrow0 = wr * 64 + fr, col0 = u.pn * BM + wc * 32 + 8 * fq; const int p0 = (u.pm - tb[u.e]) * 256, n = tb[16 + u.e];
#pragma unroll
        for (int ai = 0; ai < 2; ++ai)
#pragma unroll
            for (int m = 0; m < 4; ++m) { const int lr = lrow0 + ai * HALF + m * 16; const float gw = (p0 + lr < n) ? gsort[u.e * T + p0 + lr] : 0.f;
                bf16_t* rowp = Y + (size_t)(u.pm * 256 + lr) * D + col0;
#pragma unroll
                for (int bj = 0; bj < 2; ++bj) { const f32x4 v0 = acc[ai][bj][m][0] * gw, v1 = acc[ai][bj][m][1] * gw;
                    u32x4 w; w.x = pk2(v0[0], v0[1]); w.y = pk2(v0[2], v0[3]); w.z = pk2(v1[0], v1[1]); w.w = pk2(v1[2], v1[3]);
                    *(u32x4*)(rowp + bj * HALF) = w; } }
    }
};

template <class Epi, class Sched, bool GATHER, bool ALIGN_EPI, bool SP2>
__device__ __forceinline__ void gemm_phase(LAS unsigned char* lds, const Sched& S, const Epi& E, const int K, const int lda, const int ldb) {
    int tid_ = threadIdx.x; asm volatile("" : "+v"(tid_));
    const int tid = tid_, wid = __builtin_amdgcn_readfirstlane(tid >> 6), lane = tid & 63, wr = wid >> 2, wc = wid & 3, fr = lane & 15, fq = lane >> 4;
    const int nt = K / BK;
    unsigned voffA[2][2], voffB[2];
#pragma unroll
    for (int i = 0; i < 2; ++i) { int R, C; stage_rc(tid * 16 + i * 8192, R, C); const int Rb = Epi::PERM ? ((R & ~31) + perm32(R & 31)) : R;
        voffA[0][i] = (unsigned)(R * lda + C) * 2u; voffA[1][i] = (unsigned)((R + HALF) * lda + C) * 2u; voffB[i] = (unsigned)(Rb * ldb + C) * 2u; }
    const size_t kstep = (size_t)(BK * 2);
    const size_t hstepB = (size_t)HALF * ldb * 2;
    const unsigned ldsw = (unsigned)wid * 1024u;
    const int aoff = lds_byte(wr * 64 + fr, fq * 8), boff = lds_byte(wc * 32 + fr, fq * 8);
#define PG8_SA(b, h) (((b) * 2 + (h)) * HTB)
#define PG8_SB(b, h) ((4 + (b) * 2 + (h)) * HTB)
#define PG8_STAGE(bufoff, gbase, voff) do { _Pragma("unroll") for (int _i = 0; _i < 2; ++_i) \
        __builtin_amdgcn_global_load_lds((const unsigned*)((const char*)(gbase) + (voff)[_i]), (LAS unsigned*)(lds + (bufoff) + ldsw + _i * 8192), 16, 0, 0); } while (0)
#define PG8_LDA(dst, b, h) do { _Pragma("unroll") for (int m = 0; m < 4; ++m) _Pragma("unroll") for (int k = 0; k < 2; ++k) dst[m][k] = *(const LAS bf16x8*)(lds + PG8_SA(b, h) + aoff + m * 2048 + k * 1024); } while (0)
#define PG8_LDB(dst, b, h) do { _Pragma("unroll") for (int n = 0; n < 2; ++n) _Pragma("unroll") for (int k = 0; k < 2; ++k) dst[n][k] = *(const LAS bf16x8*)(lds + PG8_SB(b, h) + boff + n * 2048 + k * 1024); } while (0)
#define PG8_MMA(ai, bj, At, Bt) do { __builtin_amdgcn_s_setprio(1); _Pragma("unroll") for (int m = 0; m < 4; ++m) _Pragma("unroll") for (int n = 0; n < 2; ++n) _Pragma("unroll") for (int k = 0; k < 2; ++k) \
        acc[ai][bj][m][n] = __builtin_amdgcn_mfma_f32_16x16x32_bf16(Bt[n][k], At[m][k], acc[ai][bj][m][n], 0, 0, 0); __builtin_amdgcn_s_setprio(0); } while (0)
#define PG8_WAIT_V(n) asm volatile("s_waitcnt vmcnt(" #n ")" ::: "memory")
#define PG8_WAIT_L(n) asm volatile("s_waitcnt lgkmcnt(" #n ")" ::: "memory")
#define PG8_BAR __builtin_amdgcn_s_barrier()
#define PG8_SCHED __builtin_amdgcn_sched_barrier(0)
#define PG8_GOFF(dst, unit) do { _Pragma("unroll") for (int _i = 0; _i < 2; ++_i) { int _R, _C; stage_rc(tid * 16 + _i * 8192, _R, _C); \
        dst[0][_i] = (unsigned)(S.grow(unit, _R) * lda + _C) * 2u; dst[1][_i] = (unsigned)(S.grow(unit, _R + HALF) * lda + _C) * 2u; } } while (0)
    Unit cur, nxt; int ui = 0;
    if (!S.next(0, cur)) return;
    f32x4 acc[2][2][4][2];
#pragma unroll
    for (int a = 0; a < 2; ++a)
#pragma unroll
        for (int b = 0; b < 2; ++b)
#pragma unroll
            for (int m = 0; m < 4; ++m)
#pragma unroll
                for (int n = 0; n < 2; ++n) acc[a][b][m][n] = (f32x4){0.f, 0.f, 0.f, 0.f};
    bf16x8 At[4][2], B0[2][2], B1[2][2];
    const char* cA = S.a_base(cur); const char* cB = S.b_base(cur);
    if constexpr (GATHER) { PG8_GOFF(voffA, cur); }
    if constexpr (SP2) {
        PG8_STAGE(PG8_SB(0, 0), cB, voffB); PG8_STAGE(PG8_SB(0, 1), cB + hstepB, voffB); PG8_STAGE(PG8_SA(0, 0), cA, voffA[0]); PG8_STAGE(PG8_SA(0, 1), cA, voffA[1]);
        if (wr == 1) PG8_BAR;
        PG8_WAIT_V(2); PG8_BAR;
        PG8_STAGE(PG8_SB(1, 0), cB + kstep, voffB); PG8_STAGE(PG8_SA(1, 0), cA + kstep, voffA[0]); PG8_STAGE(PG8_SB(1, 1), cB + hstepB + kstep, voffB);
        PG8_WAIT_V(6); PG8_BAR;
    } else {
        PG8_STAGE(PG8_SB(0, 0), cB, voffB); PG8_STAGE(PG8_SA(0, 0), cA, voffA[0]); PG8_STAGE(PG8_SB(0, 1), cB + hstepB, voffB); PG8_STAGE(PG8_SA(0, 1), cA, voffA[1]);
        if (wr == 1) PG8_BAR;
        PG8_WAIT_V(4); PG8_BAR;
        PG8_STAGE(PG8_SB(1, 0), cB + kstep, voffB); PG8_STAGE(PG8_SA(1, 0), cA + kstep, voffA[0]); PG8_STAGE(PG8_SB(1, 1), cB + hstepB + kstep, voffB);
        PG8_WAIT_V(6); PG8_BAR;
    }
    for (;;) {
        const bool has_next = S.next(ui + 1, nxt);
        const char* nA = has_next ? S.a_base(nxt) : cA; const char* nB = has_next ? S.b_base(nxt) : cB;
        for (int t = 0; t < nt; t += 2) {
            const bool last = (t == nt - 2);
            const char* a1 = cA + (size_t)(t + 1) * kstep;
            const char* a2 = last ? nA : cA + (size_t)(t + 2) * kstep; const char* b2 = last ? nB : cB + (size_t)(t + 2) * kstep;
            const char* a3 = a2 + kstep; const char* b3 = b2 + kstep;
            unsigned nv[2][2];
            if constexpr (GATHER) { if (last && has_next) { PG8_GOFF(nv, nxt); } }
            if constexpr (SP2) {
            PG8_LDB(B0, 0, 0); PG8_LDB(B1, 0, 1); PG8_SCHED; PG8_LDA(At, 0, 0); PG8_STAGE(PG8_SA(1, 1), a1, voffA[1]);
            if constexpr (GATHER) { if (last && has_next) { voffA[0][0] = nv[0][0]; voffA[0][1] = nv[0][1]; voffA[1][0] = nv[1][0]; voffA[1][1] = nv[1][1]; } }
            PG8_WAIT_V(8); PG8_WAIT_L(0); PG8_BAR; PG8_MMA(0, 0, At, B0); PG8_MMA(0, 1, At, B1); PG8_BAR; PG8_SCHED;
            PG8_LDA(At, 0, 1); PG8_STAGE(PG8_SB(0, 0), b2, voffB); PG8_STAGE(PG8_SB(0, 1), b2 + hstepB, voffB); PG8_STAGE(PG8_SA(0, 0), a2, voffA[0]);
            PG8_WAIT_V(8); PG8_WAIT_L(0); PG8_BAR; PG8_MMA(1, 0, At, B0); PG8_MMA(1, 1, At, B1); PG8_BAR; PG8_SCHED;
            PG8_LDB(B0, 1, 0); PG8_LDB(B1, 1, 1); PG8_SCHED; PG8_LDA(At, 1, 0); PG8_STAGE(PG8_SA(0, 1), a2, voffA[1]);
            PG8_WAIT_V(8); PG8_WAIT_L(0); PG8_BAR; PG8_MMA(0, 0, At, B0); PG8_MMA(0, 1, At, B1); PG8_BAR; PG8_SCHED;
            PG8_LDA(At, 1, 1); PG8_STAGE(PG8_SB(1, 0), b3, voffB); PG8_STAGE(PG8_SB(1, 1), b3 + hstepB, voffB); PG8_STAGE(PG8_SA(1, 0), a3, voffA[0]);
            PG8_WAIT_V(8); PG8_WAIT_L(0); PG8_BAR; PG8_MMA(1, 0, At, B0); PG8_MMA(1, 1, At, B1); PG8_BAR; PG8_SCHED;
            } else {
            PG8_LDB(B0, 0, 0); PG8_SCHED; PG8_LDA(At, 0, 0); PG8_STAGE(PG8_SA(1, 1), a1, voffA[1]);
            if constexpr (GATHER) { if (last && has_next) { voffA[0][0] = nv[0][0]; voffA[0][1] = nv[0][1]; voffA[1][0] = nv[1][0]; voffA[1][1] = nv[1][1]; } }
            PG8_WAIT_L(8); PG8_BAR; PG8_WAIT_L(0); PG8_MMA(0, 0, At, B0); PG8_BAR; PG8_SCHED;
            PG8_LDB(B1, 0, 1); PG8_STAGE(PG8_SB(0, 0), b2, voffB);
            PG8_BAR; PG8_WAIT_L(0); PG8_MMA(0, 1, At, B1); PG8_BAR;
            PG8_LDA(At, 0, 1); PG8_STAGE(PG8_SA(0, 0), a2, voffA[0]);
            PG8_BAR; PG8_WAIT_L(0); PG8_MMA(1, 0, At, B0); PG8_BAR; PG8_SCHED;
            PG8_STAGE(PG8_SB(0, 1), b2 + hstepB, voffB);
            PG8_WAIT_V(6); PG8_BAR; PG8_MMA(1, 1, At, B1); PG8_BAR;
            PG8_LDB(B0, 1, 0); PG8_SCHED; PG8_LDA(At, 1, 0); PG8_STAGE(PG8_SA(0, 1), a2, voffA[1]);
            PG8_WAIT_L(8); PG8_BAR; PG8_WAIT_L(0); PG8_MMA(0, 0, At, B0); PG8_BAR; PG8_SCHED;
            PG8_LDB(B1, 1, 1); PG8_STAGE(PG8_SB(1, 0), b3, voffB);
            PG8_BAR; PG8_WAIT_L(0); PG8_MMA(0, 1, At, B1); PG8_BAR;
            PG8_LDA(At, 1, 1); PG8_STAGE(PG8_SA(1, 0), a3, voffA[0]);
            PG8_BAR; PG8_WAIT_L(0); PG8_MMA(1, 0, At, B0); PG8_BAR; PG8_SCHED;
            PG8_STAGE(PG8_SB(1, 1), b3 + hstepB, voffB);
            PG8_WAIT_V(6); PG8_BAR; PG8_MMA(1, 1, At, B1); PG8_BAR;
            }
        }
        if constexpr (ALIGN_EPI) { if (wr == 0) PG8_BAR; }
        E(acc, cur, wr, wc, fr, fq);
        if (!has_next) break;
#pragma unroll
        for (int a = 0; a < 2; ++a)
#pragma unroll
            for (int b = 0; b < 2; ++b)
#pragma unroll
                for (int m = 0; m < 4; ++m)
#pragma unroll
                    for (int n = 0; n < 2; ++n) acc[a][b][m][n] = (f32x4){0.f, 0.f, 0.f, 0.f};
        cur = nxt; cA = nA; cB = nB; ++ui;
        if constexpr (ALIGN_EPI) { if (wr == 1) PG8_BAR; }
    }
    PG8_WAIT_V(0);
    if constexpr (!ALIGN_EPI) { if (wr == 0) PG8_BAR; }
    PG8_BAR;
#undef PG8_SA
#undef PG8_SB
#undef PG8_STAGE
#undef PG8_LDA
#undef PG8_LDB
#undef PG8_MMA
#undef PG8_WAIT_V
#undef PG8_WAIT_L
#undef PG8_BAR
#undef PG8_SCHED
#undef PG8_GOFF
}
}

__device__ __forceinline__ void transpose_item(const float* W, int N, bf16_t* WT, int K, int k0, int n0, int drow0, LAS float* scr, int lane) {
#pragma unroll 8
    for (int kk = 0; kk < 64; ++kk) scr[kk * 65 + lane] = W[(size_t)(k0 + kk) * N + n0 + lane];
    LDS_WAIT(); asm volatile("" ::: "memory");
    const int c = lane & 7;
#pragma unroll
    for (int j = 0; j < 8; ++j) { const int n = (lane >> 3) + 8 * j; const LAS float* s = scr + (8 * c) * 65 + n;
        u32x4 o; o.x = pk2(s[0 * 65], s[1 * 65]); o.y = pk2(s[2 * 65], s[3 * 65]); o.z = pk2(s[4 * 65], s[5 * 65]); o.w = pk2(s[6 * 65], s[7 * 65]);
        *(u32x4*)(WT + (size_t)(drow0 + n) * K + k0 + 8 * c) = o; }
    LDS_WAIT(); asm volatile("" ::: "memory");
}
__device__ __forceinline__ bool transpose_matrix(int& it, const float* W, int K, int N, bf16_t* WT, int inter, int ioff, LAS float* scr, int lane) {
    const int nnb = N / 64, items = (K / 64) * nnb;
    if (it >= items) { it -= items; return false; }
    const int kb = it / nnb, nb = it % nnb, n0 = nb * 64;
    const int drow0 = inter ? ((n0 >> 7) * 256 + ioff + (n0 & 127)) : n0;
    transpose_item(W, N, WT, K, kb * 64, n0, drow0, scr, lane);
    return true;
}
__device__ __forceinline__ void rms_row_to_bf16(const float* xrow, const f32x4 (&gn)[4], bf16_t* orow, int lane) {
    const f32x4* xr = (const f32x4*)xrow + lane;
    f32x4 v[4]; float s = 0.f;
#pragma unroll
    for (int j = 0; j < 4; ++j) { v[j] = xr[64 * j]; s += (v[j].x * v[j].x + v[j].y * v[j].y) + (v[j].z * v[j].z + v[j].w * v[j].w); }
    const float rstd = 1.0f / sqrtf(wave_sum(s) * (1.f / D) + RMS_EPS);
    u32x2* o8 = (u32x2*)orow + lane;
#pragma unroll
    for (int j = 0; j < 4; ++j) { const f32x4 y = v[j] * rstd * gn[j]; u32x2 w; w.x = pk2(y.x, y.y); w.y = pk2(y.z, y.w); o8[64 * j] = w; }
}
__device__ __forceinline__ void rms_phase(const float* X, const float* gain, bf16_t* O, int gw, int ngw, int lane) {
    f32x4 gn[4];
#pragma unroll
    for (int j = 0; j < 4; ++j) gn[j] = ((const f32x4*)gain)[lane + 64 * j];
    for (int m = gw; m < T; m += ngw) rms_row_to_bf16(X + (size_t)m * D, gn, O + (size_t)m * D, lane);
}

__device__ __forceinline__ unsigned ks_off(int key, int c) { return (unsigned)(key * 128 + ((c ^ ((key >> 1) & 7)) << 4)); }
__device__ __forceinline__ unsigned vs_off(int key, int c) { return (unsigned)(key * 128 + ((c ^ (((key >> 1) & 1) << 2)) << 4)); }
template <int OFF> __device__ __forceinline__ void tr_read4(s16x4& a, s16x4& b, s16x4& c, s16x4& d, unsigned b0, unsigned b1) {
    asm volatile("ds_read_b64_tr_b16 %0, %4 offset:%6\n\tds_read_b64_tr_b16 %1, %4 offset:%7\n\tds_read_b64_tr_b16 %2, %5 offset:%6\n\tds_read_b64_tr_b16 %3, %5 offset:%7\n\ts_waitcnt lgkmcnt(0)"
                 : "=&v"(a), "=&v"(b), "=&v"(c), "=&v"(d) : "v"(b0), "v"(b1), "i"(OFF), "i"(OFF + 1024) : "memory");
}
__device__ __forceinline__ void attn_phase(LAS unsigned char* lds, const bf16_t* QKV, bf16_t* O, const float* sinks, int G, int bid) {
    const int tid = threadIdx.x, lane = tid & 63, wid = __builtin_amdgcn_readfirstlane(tid >> 6);
    const int g = wid >> 1, half = wid & 1, ql = lane & 31, h = lane >> 5;
    LAS unsigned char* Ks = lds; LAS unsigned char* Vs = lds + 32768;
    const int i16 = lane & 15, tq = i16 >> 2, tp = i16 & 3, blk = (lane >> 4) & 1;
    for (int u = bid; u < BATCH * 32 * NKV; u += G) {
        const int kvh = u & 3, bn = u >> 2, n = bn & 31, b = bn >> 5;
        const int tok0 = b * SEQ + n * 128;
        __syncthreads();
#pragma unroll
        for (int i = 0; i < 4; ++i) { const int q = tid + 512 * i, row = q >> 3, c = q & 7; const bool valid = (n > 0) || (row >= 128);
            u32x4 kv = (u32x4){0u, 0u, 0u, 0u}, vv = (u32x4){0u, 0u, 0u, 0u};
            if (valid) { const bf16_t* p = QKV + (size_t)(tok0 - 128 + row) * QKVW + 1024 + kvh * 64 + c * 8; kv = *(const u32x4*)p; vv = *(const u32x4*)(p + 256); }
            *(LAS u32x4*)(Ks + ks_off(row, c)) = kv; *(LAS u32x4*)(Vs + vs_off(row, c)) = vv; }
        __syncthreads();
        const int hq = kvh * 4 + g;
        const float slope2 = __builtin_amdgcn_exp2f(-0.5f * (float)(hq + 1)) * LOG2E, sink2 = sinks[hq] * LOG2E;
#pragma unroll 1
        for (int sub = 0; sub < 2; ++sub) {
            const int r0 = half * 64 + sub * 32, c0 = r0 >> 5, r = r0 + ql;
            const bf16_t* qp = QKV + (size_t)(tok0 + r) * QKVW + hq * 64 + 8 * h;
            bf16x8 qf[4];
#pragma unroll
            for (int kk = 0; kk < 4; ++kk) qf[kk] = *(const bf16x8*)(qp + 16 * kk);
            const LAS unsigned char* kb0 = Ks + c0 * 4096 + ks_off(ql, 0 + h); const LAS unsigned char* kb1 = Ks + c0 * 4096 + ks_off(ql, 2 + h);
            const LAS unsigned char* kb2 = Ks + c0 * 4096 + ks_off(ql, 4 + h); const LAS unsigned char* kb3 = Ks + c0 * 4096 + ks_off(ql, 6 + h);
            f32x16 S[5];
#pragma unroll
            for (int ck = 0; ck < 5; ++ck) {
#pragma unroll
                for (int i = 0; i < 16; ++i) S[ck][i] = 0.f;
                S[ck] = __builtin_amdgcn_mfma_f32_32x32x16_bf16(*(const LAS bf16x8*)(kb0 + 4096 * ck), qf[0], S[ck], 0, 0, 0);
                S[ck] = __builtin_amdgcn_mfma_f32_32x32x16_bf16(*(const LAS bf16x8*)(kb1 + 4096 * ck), qf[1], S[ck], 0, 0, 0);
                S[ck] = __builtin_amdgcn_mfma_f32_32x32x16_bf16(*(const LAS bf16x8*)(kb2 + 4096 * ck), qf[2], S[ck], 0, 0, 0);
                S[ck] = __builtin_amdgcn_mfma_f32_32x32x16_bf16(*(const LAS bf16x8*)(kb3 + 4096 * ck), qf[3], S[ck], 0, 0, 0);
            }
            const int bd = 128 + ql - 4 * h, jb = 32 * c0 + 4 * h; const float nb = -slope2 * (float)bd;
            float mx = sink2;
#pragma unroll
            for (int ck = 0; ck < 5; ++ck)
#pragma unroll
                for (int i = 0; i < 16; ++i) { const int kc = 32 * ck + (i & 3) + 8 * (i >> 2);
                    const bool valid = (kc <= bd) && (kc > bd - 128) && ((n > 0) || (jb + kc >= 128));
                    const float s = valid ? (S[ck][i] + nb + slope2 * (float)kc) : -1e30f; S[ck][i] = s; mx = fmaxf(mx, s); }
            mx = fmaxf(mx, __shfl_xor(mx, 32));
            float l = 0.f;
            bf16x8 pf[5][2];
#pragma unroll
            for (int ck = 0; ck < 5; ++ck)
#pragma unroll
                for (int s = 0; s < 2; ++s) { float p[8];
#pragma unroll
                    for (int i = 0; i < 8; ++i) { p[i] = __builtin_amdgcn_exp2f(S[ck][8 * s + i] - mx); l += p[i]; }
                    u32x4 pw; pw.x = pk2(p[0], p[1]); pw.y = pk2(p[2], p[3]); pw.z = pk2(p[4], p[5]); pw.w = pk2(p[6], p[7]);
                    pf[ck][s] = __builtin_bit_cast(bf16x8, pw); }
            l += __shfl_xor(l, 32); l += __builtin_amdgcn_exp2f(sink2 - mx);
            const float inv = 1.0f / l;
            f32x16 o0, o1;
#pragma unroll
            for (int i = 0; i < 16; ++i) { o0[i] = 0.f; o1[i] = 0.f; }
            const unsigned vb0 = (unsigned)(size_t)Vs + c0 * 4096 + vs_off(4 * h + tq, 2 * blk + (tp >> 1)) + 8 * (tp & 1);
            const unsigned vb1 = (unsigned)(size_t)Vs + c0 * 4096 + vs_off(4 * h + tq, 4 + 2 * blk + (tp >> 1)) + 8 * (tp & 1);
#define ATT_PV(ck, s) do { s16x4 lo0, hi0, lo1, hi1; tr_read4<4096 * (ck) + 2048 * (s)>(lo0, hi0, lo1, hi1, vb0, vb1); \
                const bf16x8 v0 = __builtin_shufflevector(lo0, hi0, 0, 1, 2, 3, 4, 5, 6, 7), v1 = __builtin_shufflevector(lo1, hi1, 0, 1, 2, 3, 4, 5, 6, 7); \
                o0 = __builtin_amdgcn_mfma_f32_32x32x16_bf16(v0, pf[ck][s], o0, 0, 0, 0); o1 = __builtin_amdgcn_mfma_f32_32x32x16_bf16(v1, pf[ck][s], o1, 0, 0, 0); } while (0)
            ATT_PV(0, 0); ATT_PV(0, 1); ATT_PV(1, 0); ATT_PV(1, 1); ATT_PV(2, 0); ATT_PV(2, 1); ATT_PV(3, 0); ATT_PV(3, 1); ATT_PV(4, 0); ATT_PV(4, 1);
#undef ATT_PV
            bf16_t* op = O + (size_t)(tok0 + r) * D + hq * 64 + 4 * h;
#pragma unroll
            for (int g4 = 0; g4 < 4; ++g4) {
                u32x2 w0; w0.x = pk2(o0[4 * g4 + 0] * inv, o0[4 * g4 + 1] * inv); w0.y = pk2(o0[4 * g4 + 2] * inv, o0[4 * g4 + 3] * inv);
                u32x2 w1; w1.x = pk2(o1[4 * g4 + 0] * inv, o1[4 * g4 + 1] * inv); w1.y = pk2(o1[4 * g4 + 2] * inv, o1[4 * g4 + 3] * inv);
                *(u32x2*)(op + 8 * g4) = w0; *(u32x2*)(op + 32 + 8 * g4) = w1; }
        }
    }
}

__device__ __forceinline__ void pool_phase(LAS unsigned char* lds, const float* X, const float* gain, bf16_t* P, int G, int bid) {
    const int tid = threadIdx.x, lane = tid & 63, wid = __builtin_amdgcn_readfirstlane(tid >> 6);
    LAS float* rs = (LAS float*)lds;
    const int c = 2 * tid, w = 2 << (tid >> 7);
    const f32x2 gn = *(const f32x2*)(gain + c);
    for (int ch = bid; ch < T / 128; ch += G) {
        const int row0 = ch * 128, spos0 = row0 & (SEQ - 1), halo = spos0 ? 15 : 0;
        __syncthreads();
        for (int i = -halo + wid; i < 128; i += 8) { const f32x4* xr = (const f32x4*)(X + (size_t)(row0 + i) * D) + lane; float s = 0.f;
#pragma unroll
            for (int j = 0; j < 4; ++j) { const f32x4 v = xr[64 * j]; s += (v.x * v.x + v.y * v.y) + (v.z * v.z + v.w * v.w); }
            s = wave_sum(s); if (lane == 0) rs[i + 15] = 1.0f / sqrtf(s * (1.f / D) + RMS_EPS); }
        __syncthreads();
        const int istart = halo ? -(w - 1) : 0;
        f32x2 S = (f32x2){0.f, 0.f};
        for (int i = istart; i < 128; ++i) {
            const f32x2 v = *(const f32x2*)(X + (size_t)(row0 + i) * D + c) * rs[i + 15] * gn;
            S += v;
            if (i - w >= istart) { const f32x2 vo = *(const f32x2*)(X + (size_t)(row0 + i - w) * D + c) * rs[i - w + 15] * gn; S -= vo; }
            if (i >= 0) { const int pos = spos0 + i + 1; const float cnt = (float)(pos < w ? pos : w); const f32x2 pv = S / cnt - v;
                *(unsigned*)(P + (size_t)(row0 + i) * D + c) = pk2(pv.x, pv.y); }
        }
    }
}

__device__ __forceinline__ void router_phase(LAS unsigned char* lds, volatile LAS unsigned* MISC, const float* X, const float* gain, const float* wr, bf16_t* H,
                                             unsigned* gcnt, int* list, float* gsort, int* tokinfo, int G, int bid) {
    const int tid = threadIdx.x, lane = tid & 63, wid = __builtin_amdgcn_readfirstlane(tid >> 6);
    LAS float* wl = (LAS float*)lds;
    __syncthreads();
    for (int i = tid; i < D * NE / 4; i += 512) ((LAS f32x4*)wl)[i] = ((const f32x4*)wr)[i];
    f32x4 gn[4];
#pragma unroll
    for (int j = 0; j < 4; ++j) gn[j] = ((const f32x4*)gain)[lane + 64 * j];
    volatile LAS unsigned* lcnt = MISC + 32; volatile LAS unsigned* lbase = MISC + 40;
    for (int ch = bid; ch < T / 128; ch += G) {
        if (tid < 8) lcnt[tid] = 0u;
        __syncthreads();
        int me1 = 0, me2 = 0; float mg1 = 0.f, mg2 = 0.f;
        for (int i = 0; i < 16; ++i) {
            const int t = ch * 128 + wid * 16 + i;
            const f32x4* xr = (const f32x4*)(X + (size_t)t * D) + lane;
            f32x4 v[4]; float s = 0.f;
#pragma unroll
            for (int j = 0; j < 4; ++j) { v[j] = xr[64 * j]; s += (v[j].x * v[j].x + v[j].y * v[j].y) + (v[j].z * v[j].z + v[j].w * v[j].w); }
            const float rstd = 1.0f / sqrtf(wave_sum(s) * (1.f / D) + RMS_EPS);
            float lg[8];
#pragma unroll
            for (int e = 0; e < 8; ++e) lg[e] = 0.f;
            u32x2* o8 = (u32x2*)(H + (size_t)t * D) + lane;
#pragma unroll
            for (int j = 0; j < 4; ++j) { const f32x4 y = v[j] * rstd * gn[j]; u32x2 w; w.x = pk2(y.x, y.y); w.y = pk2(y.z, y.w); o8[64 * j] = w;
#pragma unroll
                for (int q = 0; q < 4; ++q) { const LAS f32x4* wp = (const LAS f32x4*)(wl + (size_t)(4 * lane + 256 * j + q) * 8); const f32x4 wa = wp[0], wb = wp[1]; const float yq = y[q];
                    lg[0] += yq * wa.x; lg[1] += yq * wa.y; lg[2] += yq * wa.z; lg[3] += yq * wa.w; lg[4] += yq * wb.x; lg[5] += yq * wb.y; lg[6] += yq * wb.z; lg[7] += yq * wb.w; } }
#pragma unroll
            for (int e = 0; e < 8; ++e) lg[e] = wave_sum(lg[e]);
            int e1 = 0; float v1 = lg[0];
#pragma unroll
            for (int e = 1; e < 8; ++e) if (lg[e] > v1) { v1 = lg[e]; e1 = e; }
            int e2 = -1; float v2 = -3.0e38f;
#pragma unroll
            for (int e = 0; e < 8; ++e) if (e != e1 && lg[e] > v2) { v2 = lg[e]; e2 = e; }
            const float g2 = 1.0f / (1.0f + __expf(v1 - v2)), g1 = 1.0f - g2;
            if (lane == i) { me1 = e1; me2 = e2; mg1 = g1; mg2 = g2; }
        }
        unsigned lp1 = 0, lp2 = 0;
        if (lane < 16) { lp1 = atomicAdd((unsigned*)(MISC + 32 + me1), 1u); lp2 = atomicAdd((unsigned*)(MISC + 32 + me2), 1u); }
        __syncthreads();
        if (tid < 8) lbase[tid] = __hip_atomic_fetch_add(gcnt + 64 * tid, lcnt[tid], RLX_AGENT);
        __syncthreads();
        if (lane < 16) { const int t = ch * 128 + wid * 16 + lane; const int p1 = (int)(lbase[me1] + lp1), p2 = (int)(lbase[me2] + lp2);
            list[me1 * T + p1] = t; gsort[me1 * T + p1] = mg1; list[me2 * T + p2] = t; gsort[me2 * T + p2] = mg2;
            tokinfo[2 * t] = (me1 << 20) | p1; tokinfo[2 * t + 1] = (me2 << 20) | p2; }
        __syncthreads();
    }
}
__device__ __forceinline__ void moe_tiles(volatile LAS int* tb, unsigned* gcnt) {
    __syncthreads();
    if (threadIdx.x == 0) { int a = 0;
        for (int e = 0; e < 8; ++e) { const int c = (int)__hip_atomic_load(gcnt + 64 * e, RLX_AGENT); tb[e] = a; tb[16 + e] = c; a += (c + 255) >> 8; }
        tb[8] = a; }
    __syncthreads();
}
__device__ __forceinline__ void combine_phase(volatile LAS int* tb, float* X, const bf16_t* Y, const int* tokinfo, const float* gain, int gw, int ngw, int lane) {
    f32x4 gn[4];
#pragma unroll
    for (int j = 0; j < 4; ++j) gn[j] = ((const f32x4*)gain)[lane + 64 * j];
    for (int t = gw; t < T; t += ngw) {
        const int i0 = tokinfo[2 * t], i1 = tokinfo[2 * t + 1];
        const int s0 = tb[i0 >> 20] * 256 + (i0 & 0xFFFFF), s1 = tb[i1 >> 20] * 256 + (i1 & 0xFFFFF);
        f32x4* xr = (f32x4*)(X + (size_t)t * D) + lane; const u32x2* y0 = (const u32x2*)(Y + (size_t)s0 * D) + lane; const u32x2* y1 = (const u32x2*)(Y + (size_t)s1 * D) + lane;
        f32x4 v[4]; float s = 0.f;
#pragma unroll
        for (int j = 0; j < 4; ++j) { const u32x2 a = y0[64 * j], b = y1[64 * j]; f32x4 x = xr[64 * j];
            x.x += __uint_as_float(a.x << 16) + __uint_as_float(b.x << 16); x.y += __uint_as_float(a.x & 0xFFFF0000u) + __uint_as_float(b.x & 0xFFFF0000u);
            x.z += __uint_as_float(a.y << 16) + __uint_as_float(b.y << 16); x.w += __uint_as_float(a.y & 0xFFFF0000u) + __uint_as_float(b.y & 0xFFFF0000u);
            v[j] = x; s += (x.x * x.x + x.y * x.y) + (x.z * x.z + x.w * x.w); }
        const float rstd = 1.0f / sqrtf(wave_sum(s) * (1.f / D) + RMS_EPS);
#pragma unroll
        for (int j = 0; j < 4; ++j) xr[64 * j] = v[j] * rstd * gn[j];
    }
}

constexpr int NPHASE = 10 + 2 * NPASS + 1;
struct Args { const float* in[18]; float* out; unsigned char* ws; int ph_lo, ph_hi; };
__global__ void __launch_bounds__(512, 2) trunk_fwd(Args args) {
    extern __shared__ __attribute__((aligned(16))) unsigned char lds_raw[];
    LAS unsigned char* lds = (LAS unsigned char*)lds_raw;
    volatile LAS unsigned* MISC = (volatile LAS unsigned*)(lds + MISC_OFF);
    const int tid = threadIdx.x, lane = tid & 63, wave = __builtin_amdgcn_readfirstlane(tid >> 6);
    const int G = gridDim.x, bid = blockIdx.x;
    const int gw = bid * 8 + wave, ngw = G * 8;
    unsigned char* ws = args.ws;
    unsigned* ctl = (unsigned*)(ws + WS_CTL);
    for (int u = tid; u < (LDS_BYTES - MISC_OFF) / 4; u += 512) MISC[u] = 0u;
    __syncthreads();
#if MK_PER_PHASE
#define GRID_BAR() do { } while (0)
#else
    XcdBarrier bar = xcd_barrier_post(ctl + CW_BAR, MISC);
#define GRID_BAR() xcd_barrier(bar)
#endif
    const float* x_in = args.in[0]; float* out = args.out;
    bf16_t* Wqkv = (bf16_t*)(ws + WS_WQKV); bf16_t* Wo = (bf16_t*)(ws + WS_WO); bf16_t* Wgu = (bf16_t*)(ws + WS_WGU); bf16_t* Wd = (bf16_t*)(ws + WS_WD); bf16_t* Wp = (bf16_t*)(ws + WS_WP);
    bf16_t* Mgu = (bf16_t*)(ws + WS_MGU); bf16_t* Md = (bf16_t*)(ws + WS_MD);
    bf16_t* HB = (bf16_t*)(ws + WS_HB); bf16_t* QKV = (bf16_t*)(ws + WS_B); bf16_t* ACT = (bf16_t*)(ws + WS_B); bf16_t* Yb = (bf16_t*)(ws + WS_Y); bf16_t* MACT = (bf16_t*)(ws + WS_MACT);
    int* list = (int*)(ws + WS_LIST); float* gsort = (float*)(ws + WS_GSORT); int* tokinfo = (int*)(ws + WS_TOKINFO);
    unsigned* gcnt = ctl + CW_CNT;
    volatile LAS int* tb = (volatile LAS int*)(MISC + 8);
    const int lo = args.ph_lo, hi = args.ph_hi;
#ifndef PHMASK
#define PHMASK 0xFFFFFFFFu
#endif
#define IN(k) ((((PHMASK) >> ((k) < 10 ? (k) : (10 + (((k) - 10) & 1)))) & 1u) && lo <= (k) && (k) < hi)
#define SEAM(k) do { if (IN(k) && IN((k) + 1)) GRID_BAR(); } while (0)

    if (IN(0)) {
        LAS float* scr = (LAS float*)(lds + wave * 16640);
        constexpr int I_QKV = 16 * 24, I_O = 16 * 16, I_G = 16 * 44, I_D = 44 * 16, I_P = 4 * 16, I_MG = 16 * 56, I_MD = 56 * 16;
        constexpr int NITEMS = I_QKV + I_O + 2 * I_G + I_D + I_P + NE * (2 * I_MG + I_MD);
        for (int item = gw; item < NITEMS; item += ngw) {
            int it = item;
            if (transpose_matrix(it, args.in[2], D, QKVW, Wqkv, 0, 0, scr, lane)) continue;
            if (transpose_matrix(it, args.in[4], D, D, Wo, 0, 0, scr, lane)) continue;
            if (transpose_matrix(it, args.in[6], D, DFF, Wgu, 1, 0, scr, lane)) continue;
            if (transpose_matrix(it, args.in[7], D, DFF, Wgu, 1, 128, scr, lane)) continue;
            if (transpose_matrix(it, args.in[8], DFF, D, Wd, 0, 0, scr, lane)) continue;
            if (it < I_P) { const int g = it / 16; int r = it % 16; transpose_matrix(r, args.in[10] + (size_t)g * 256 * 256, 256, 256, Wp + (size_t)g * 256 * 256, 0, 0, scr, lane); continue; }
            it -= I_P;
            { const int per = 2 * I_MG + I_MD, e = it / per; int r = it % per;
              if (transpose_matrix(r, args.in[14] + (size_t)e * D * DFE, D, DFE, Mgu + (size_t)e * 2 * DFE * D, 1, 0, scr, lane)) continue;
              if (transpose_matrix(r, args.in[15] + (size_t)e * D * DFE, D, DFE, Mgu + (size_t)e * 2 * DFE * D, 1, 128, scr, lane)) continue;
              transpose_matrix(r, args.in[16] + (size_t)e * DFE * D, DFE, D, Md + (size_t)e * D * DFE, 0, 0, scr, lane); }
        }
        rms_phase(x_in, args.in[1], HB, gw, ngw, lane);
    }
    SEAM(0);
    if (IN(1)) {
        pg8::DenseOrder S{HB, Wqkv, D, D, T / 256, QKVW / 256, G, bid, 0}; pg8::EpiQKV E{QKV};
        pg8::gemm_phase<pg8::EpiQKV, pg8::DenseOrder, false, true, true>(lds, S, E, D, D, D);
    }
    SEAM(1);
    if (IN(2)) attn_phase(lds, QKV, HB, args.in[3], G, bid);
    SEAM(2);
    if (IN(3)) {
        pg8::DenseOrder S{HB, Wo, D, D, T / 256, D / 256, G, bid, 0}; pg8::EpiResF32 E{x_in, out, nullptr};
        pg8::gemm_phase<pg8::EpiResF32, pg8::DenseOrder, false, true, true>(lds, S, E, D, D, D);
    }
    SEAM(3);
    if (IN(4)) rms_phase(out, args.in[5], HB, gw, ngw, lane);
    SEAM(4);
    if (IN(5)) {
        pg8::DenseOrder S{HB, Wgu, D, D, T / 256, 2 * DFF / 256, G, bid, 0}; pg8::EpiSwiGLU E{ACT, DFF, 0};
        pg8::gemm_phase<pg8::EpiSwiGLU, pg8::DenseOrder, false, true, true>(lds, S, E, D, D, D);
    }
    SEAM(5);
    if (IN(6)) {
        pg8::DenseOrder S{ACT, Wd, DFF, DFF, T / 256, D / 256, G, bid, 0}; pg8::EpiResF32 E{out, out, nullptr};
        pg8::gemm_phase<pg8::EpiResF32, pg8::DenseOrder, false, true, true>(lds, S, E, DFF, DFF, DFF);
    }
    SEAM(6);
    if (IN(7)) pool_phase(lds, out, args.in[9], HB, G, bid);
    SEAM(7);
    if (IN(8)) {
        pg8::DenseOrder S{HB, Wp, D, 256, T / 256, 4, G, bid, 1}; pg8::EpiResF32 E{out, out, args.in[11]};
        pg8::gemm_phase<pg8::EpiResF32, pg8::DenseOrder, false, true, true>(lds, S, E, 256, D, 256);
    }
    SEAM(8);
    if (IN(9)) router_phase(lds, MISC, out, args.in[12], args.in[13], HB, gcnt, list, gsort, tokinfo, G, bid);
    SEAM(9);
    if (hi > 10) moe_tiles(tb, gcnt);
    {
        const int Gt = tb[8], TP = (Gt + NPASS - 1) / NPASS;
#pragma unroll 1
        for (int p = 0; p < NPASS; ++p) {
            const int t0 = p * TP, t1 = (t0 + TP < Gt) ? t0 + TP : Gt, ntile = t1 - t0;
            if (IN(10 + 2 * p) && ntile > 0) {
                pg8::MoeOrder S{HB, Mgu, D, D, ntile, 2 * DFE / 256, G, bid, t0, (size_t)2 * DFE * D, tb, list, 1}; pg8::EpiSwiGLU E{MACT, DFE, t0};
                pg8::gemm_phase<pg8::EpiSwiGLU, pg8::MoeOrder, true, true, true>(lds, S, E, D, D, D);
            }
            SEAM(10 + 2 * p);
            if (IN(11 + 2 * p) && ntile > 0) {
                pg8::MoeOrder S{MACT, Md, DFE, DFE, ntile, D / 256, G, bid, t0, (size_t)D * DFE, tb, list, 0}; pg8::EpiMoeDown E{Yb, gsort, tb};
                pg8::gemm_phase<pg8::EpiMoeDown, pg8::MoeOrder, false, true, true>(lds, S, E, DFE, DFE, DFE);
            }
            SEAM(11 + 2 * p);
        }
    }
    if (IN(NPHASE - 1)) combine_phase(tb, out, Yb, tokinfo, args.in[17], gw, ngw, lane);
#undef IN
#undef SEAM
}

extern "C" void kernel_launch(void* const* d_in, const int* in_sizes, int n_in, void* d_out, int out_size, void* d_ws, size_t ws_size, hipStream_t stream) {
    static int grid = 0;
    if (grid == 0) {
        if (n_in != 18 || in_sizes[0] != T * D || out_size != T * D || ws_size < WS_END) { fprintf(stderr, "kernel_launch: unexpected shapes / workspace (%d inputs, ws %zu < %zu)\n", n_in, ws_size, (size_t)WS_END); grid = -1; return; }
        int dev = 0, cus = 0, per_cu = 0;
        if (hipGetDevice(&dev) != hipSuccess || hipDeviceGetAttribute(&cus, hipDeviceAttributeMultiprocessorCount, dev) != hipSuccess) { grid = -1; return; }
        if (hipFuncSetAttribute((const void*)trunk_fwd, hipFuncAttributeMaxDynamicSharedMemorySize, LDS_BYTES) != hipSuccess) { fprintf(stderr, "kernel_launch: hipFuncSetAttribute failed\n"); grid = -1; return; }
        if (hipOccupancyMaxActiveBlocksPerMultiprocessor(&per_cu, (const void*)trunk_fwd, 512, LDS_BYTES) != hipSuccess || per_cu < 1) fprintf(stderr, "kernel_launch: occupancy query reports %d\n", per_cu);
        (void)hipGetLastError();
        grid = cus;
    }
    if (grid < 0) return;
    if (hipMemsetAsync((char*)d_ws + WS_CTL, 0, CTL_ZERO_BYTES, stream) != hipSuccess) return;
    Args a{};
    for (int i = 0; i < 18; ++i) a.in[i] = (const float*)d_in[i];
    a.out = (float*)d_out; a.ws = (unsigned char*)d_ws;
#if MK_PER_PHASE
    for (int ph = 0; ph < NPHASE; ++ph) { a.ph_lo = ph; a.ph_hi = ph + 1; hipLaunchKernelGGL(trunk_fwd, dim3(grid), dim3(512), LDS_BYTES, stream, a); }
#else
    a.ph_lo = 0; a.ph_hi = NPHASE;
    hipLaunchKernelGGL(trunk_fwd, dim3(grid), dim3(512), LDS_BYTES, stream, a);
#endif
}
```

```cpp
#include <hip/hip_runtime.h>
#include <cstdio>
#include <cstdint>

#ifndef MK_PER_PHASE
#define MK_PER_PHASE 0
#endif

#ifndef PROBE_REPEAT
#define PROBE_REPEAT -1
#endif
#define REPS(k) ((PROBE_REPEAT) == (k) ? 2 : 1)
#define LAS __attribute__((address_space(3)))
#define GAS __attribute__((address_space(1)))
typedef unsigned short bf16_t;
typedef short bf16x8 __attribute__((ext_vector_type(8)));
typedef short s16x4 __attribute__((ext_vector_type(4)));
typedef float f32x4 __attribute__((ext_vector_type(4)));
typedef float f32x2 __attribute__((ext_vector_type(2)));
typedef float f32x16 __attribute__((ext_vector_type(16)));
typedef unsigned u32x4 __attribute__((ext_vector_type(4)));
typedef unsigned u32x2 __attribute__((ext_vector_type(2)));
typedef __bf16 bf16v2 __attribute__((ext_vector_type(2)));
typedef int i32x8 __attribute__((ext_vector_type(8)));
typedef int i32x4 __attribute__((ext_vector_type(4)));

constexpr int BATCH = 8, SEQ = 4096, T = BATCH * SEQ, D = 1024, QKVW = 1536, DFF = 2816, NE = 8, DFE = 3584, NHEAD = 16, NKV = 4, HD = 64;
constexpr float RMS_EPS = 1e-5f, LOG2E = 1.4426950408889634f;
constexpr float QSCALE = 0.125f * LOG2E;
constexpr int NPASS = 5, TPMAX = 53, GMAX = 264;

constexpr size_t MiB = 1u << 20;
constexpr size_t WS_CTL = 0, CTL_ZERO_BYTES = 1 * MiB;
constexpr size_t WS_LIST = 1 * MiB;
constexpr size_t WS_GSORT = 2 * MiB;
constexpr size_t WS_TOKINFO = 3 * MiB;
constexpr size_t WS_WQKV = 4 * MiB;
constexpr size_t WS_WO = 7 * MiB;
constexpr size_t WS_WGU = 9 * MiB;
constexpr size_t WS_WD = 20 * MiB;
constexpr size_t WS_WP = 26 * MiB;
constexpr size_t WS_MGU = 27 * MiB;
constexpr size_t WS_MD = 83 * MiB;
constexpr size_t WS_HB = 195 * MiB;
constexpr size_t WS_B = 259 * MiB;
constexpr size_t WS_Y = WS_B, WS_MACT = WS_B + 132 * MiB;
constexpr size_t WS_END = WS_MACT + (size_t)TPMAX * 256 * DFE;
static_assert(WS_END <= 512 * MiB, "workspace");
static_assert((size_t)GMAX * 256 * D * 2 <= 132 * MiB, "y");
static_assert(WS_MGU + (size_t)NE * 2 * DFE * D <= WS_MD && WS_MD + (size_t)NE * D * DFE <= WS_HB && WS_HB + (size_t)T * D * 2 <= WS_B, "map");
static_assert(WS_B + (size_t)T * DFF * 2 <= 512 * MiB, "act");
constexpr int CW_TMO = 0;
constexpr int CW_BAR = 4096;
constexpr int CW_CNT = 16384;

constexpr int RING_BYTES = 131072;
constexpr int LDS_BYTES = 147456;
constexpr int MISC_OFF = 146432;

#define RLX_AGENT __ATOMIC_RELAXED, __HIP_MEMORY_SCOPE_AGENT
#define LDS_WAIT() asm volatile("s_waitcnt lgkmcnt(0)" ::: "memory")
#define VM_WAIT() asm volatile("s_waitcnt vmcnt(0)" ::: "memory")

__device__ __forceinline__ unsigned pk2(float lo, float hi) { bf16v2 v = {(__bf16)lo, (__bf16)hi}; return __builtin_bit_cast(unsigned, v); }
constexpr float W8_SCALE = 64.0f, W8_INV = 1.0f / 64.0f;
__device__ __forceinline__ float clamp8(float x) { return __builtin_fminf(__builtin_fmaxf(x, -448.0f), 448.0f); }
__device__ __forceinline__ unsigned pk4_fp8(float a, float b, float c, float d) {
    unsigned w = 0u; w = (unsigned)__builtin_amdgcn_cvt_pk_fp8_f32(clamp8(a), clamp8(b), (int)w, false); w = (unsigned)__builtin_amdgcn_cvt_pk_fp8_f32(clamp8(c), clamp8(d), (int)w, true); return w; }
__device__ __forceinline__ float wave_sum(float v) {
#pragma unroll
    for (int o = 1; o < 64; o <<= 1) v += __shfl_xor(v, o);
    return v;
}

#define XB_TMO      128
#define XB_XCNT(j)  (256  + 64 * (j))
#define XB_XSUB(j)  (1280 + 64 * (j))
#define XB_XGEN(j)  (2304 + 64 * (j))
#define XB_TOP      3328
#define XB_TOPGEN   3392
#define XCD_BAR_WORDS 3456
#define XB_SPIN_CAP (1u << 18)
__device__ __forceinline__ unsigned xb_ld(unsigned* p)              { return __hip_atomic_load(p, __ATOMIC_RELAXED, __HIP_MEMORY_SCOPE_AGENT); }
__device__ __forceinline__ unsigned xb_add(unsigned* p, unsigned v) { return __hip_atomic_fetch_add(p, v, __ATOMIC_RELAXED, __HIP_MEMORY_SCOPE_AGENT); }
__device__ __forceinline__ unsigned xb_xcc_id() { return (unsigned)__builtin_amdgcn_s_getreg((3 << 11) | 20) & 0xFu; }
#define XB_SPIN(cond, bar) do { unsigned _sp = 0; while (cond) { __builtin_amdgcn_s_sleep(1); \
    if ((++_sp & 255u) == 0u) { if (xb_ld(&(bar)[XB_TMO])) break; if (_sp > XB_SPIN_CAP) { atomicAdd(&(bar)[XB_TMO], 1u); break; } } } } while (0)
struct XcdBarrier { unsigned* bar; unsigned x; volatile LAS unsigned* st; };
__device__ __forceinline__ XcdBarrier xcd_barrier_post(unsigned* bar, volatile LAS unsigned* st) {
    XcdBarrier b; b.bar = bar; b.x = xb_xcc_id(); b.st = st;
    if (threadIdx.x == 0) (void)xb_add(&bar[XB_XCNT(b.x)], 1u);
    return b;
}
__device__ __forceinline__ void xcd_barrier_complete(unsigned* bar, unsigned x, unsigned& nloc, unsigned& nx) {
    const unsigned G = gridDim.x * gridDim.y * gridDim.z;
    unsigned sum, cnt, mine, sp = 0u;
    for (;;) {
        sum = 0u; cnt = 0u; mine = 0u;
#pragma unroll
        for (unsigned j = 0; j < 16; ++j) { const unsigned c = xb_ld(&bar[XB_XCNT(j)]); sum += c; cnt += (c > 0u) ? 1u : 0u; mine = (j == x) ? c : mine; }
        if (sum == G) break;
        __builtin_amdgcn_s_sleep(1);
        if ((++sp & 255u) == 0u) { if (xb_ld(&bar[XB_TMO])) break; if (sp > XB_SPIN_CAP) { atomicAdd(&bar[XB_TMO], 1u); break; } }
    }
    nloc = mine > 0u ? mine : 1u; nx = cnt > 0u ? cnt : 1u;
}
__device__ __forceinline__ void xcd_barrier(const XcdBarrier& b) {
    asm volatile("s_waitcnt vmcnt(0)" ::: "memory");
    __syncthreads();
    if (threadIdx.x == 0) {
        unsigned* bar = b.bar;
        __builtin_amdgcn_s_waitcnt(0);
        unsigned nloc = b.st[0], nx = b.st[1];
        if (nloc == 0u) { xcd_barrier_complete(bar, b.x, nloc, nx); b.st[0] = nloc; b.st[1] = nx; }
        const unsigned old = xb_add(&bar[XB_XSUB(b.x)], 1u);
        const unsigned gen = old / nloc;
        if (old + 1u == (gen + 1u) * nloc) {
            __builtin_amdgcn_fence(__ATOMIC_RELEASE, "agent");
            asm volatile("s_waitcnt vmcnt(0)" ::: "memory");
            const unsigned og = xb_add(&bar[XB_TOP], 1u);
            const unsigned tg = og / nx;
            if (og + 1u == (tg + 1u) * nx) xb_add(&bar[XB_TOPGEN], 1u);
            else XB_SPIN(xb_ld(&bar[XB_TOPGEN]) == tg, bar);
            __builtin_amdgcn_fence(__ATOMIC_ACQUIRE, "agent");
            xb_add(&bar[XB_XGEN(b.x)], 1u);
            asm volatile("s_waitcnt vmcnt(0)" ::: "memory");
        } else {
            XB_SPIN(xb_ld(&bar[XB_XGEN(b.x)]) == gen, bar);
            __builtin_amdgcn_fence(__ATOMIC_ACQUIRE, "agent");
            asm volatile("s_waitcnt vmcnt(0)" ::: "memory");
        }
    }
    __syncthreads();
}

namespace pg8 {
constexpr int BM = 256, BK = 64, HALF = 128, HTB = HALF * BK * 2, NXCD = 8, WGM = 8;
__device__ __forceinline__ int lds_byte(int r, int c) { const int st = (r >> 4) * 2 + (c >> 5), rr = r & 15, cc = c & 31, ob = rr * 64 + cc * 2; return st * 1024 + (ob ^ (((ob >> 9) & 1) << 5)); }
__device__ __forceinline__ void stage_rc(int b, int& R, int& C) { const int st = b / 1024, sb = b % 1024, swz = sb ^ (((sb >> 9) & 1) << 5); R = (st >> 1) * 16 + swz / 64; C = (st & 1) * 32 + (swz % 64) / 2; }
__device__ __forceinline__ int perm32(int rho) { const int n = rho >> 4, i = rho & 15; return 8 * (i >> 2) + 4 * n + (i & 3); }

struct Unit { int pm, pn, e; };

__device__ __forceinline__ bool tile_of(int i, int G, int c, int nM, int nN, int& pm, int& pn) {
    const int nwg = nM * nN; const long L = (long)i * G + c; if (L >= nwg) return false;
    int wgid = (int)L; { const int q = nwg / NXCD, r = nwg % NXCD, xcd = wgid % NXCD, off = wgid / NXCD; wgid = (xcd < r ? xcd * (q + 1) : r * (q + 1) + (xcd - r) * q) + off; }
    const int nig = WGM * nN, gid = wgid / nig, fm = gid * WGM, gsz = (nM - fm) < WGM ? (nM - fm) : WGM;
    pm = fm + ((wgid % nig) % gsz); pn = (wgid % nig) / gsz; return true;
}
struct DenseOrder {
    const char* A; const char* Bt; int lda, ldb, nM, nN, G, c; int grouped;
    __device__ __forceinline__ bool next(int i, Unit& u) const { u.e = 0; return tile_of(i, G, c, nM, nN, u.pm, u.pn); }
    __device__ __forceinline__ const char* a_base(const Unit& u) const { return A + (size_t)u.pm * 256 * lda + (grouped ? u.pn * 512 : 0); }
    __device__ __forceinline__ const char* b_base(const Unit& u) const { return Bt + (size_t)u.pn * 256 * ldb; }
    __device__ __forceinline__ int grow(const Unit&, int) const { return 0; }
};
struct MoeOrder {
    const char* A; const char* Bt; int lda, ldb, nM, nN, G, c, t0; size_t bstride;
    const volatile LAS int* tb; const int* list; int gather;
    __device__ __forceinline__ bool next(int i, Unit& u) const {
        if (!tile_of(i, G, c, nM, nN, u.pm, u.pn)) return false;
        u.pm += t0; int e = 0;
#pragma unroll
        for (int j = 1; j < 8; ++j) e += (u.pm >= tb[j]) ? 1 : 0;
        u.e = __builtin_amdgcn_readfirstlane(e); return true;
    }
    __device__ __forceinline__ const char* a_base(const Unit& u) const { return gather ? A : A + (size_t)(u.pm - t0) * 256 * lda; }
    __device__ __forceinline__ const char* b_base(const Unit& u) const { return Bt + (size_t)u.e * bstride + (size_t)u.pn * 256 * ldb; }
    __device__ __forceinline__ int grow(const Unit& u, int r) const {
        const int tbe = __builtin_amdgcn_readfirstlane(tb[u.e]), n = __builtin_amdgcn_readfirstlane(tb[16 + u.e]);
        int p = (u.pm - tbe) * 256 + r; p = p < n ? p : n - 1;
        return list[u.e * T + p];
    }
};

struct EpiQKV {
    static constexpr bool PERM = true; static constexpr int PROBE_ID = 1;
    bf16_t* O;
    __device__ __forceinline__ void operator()(const f32x4 (&acc)[2][2][4][2], const Unit& u, int wr, int wc, int fr, int fq) const {
        const int row0 = u.pm * BM + wr * 64 + fr, col0 = u.pn * BM + wc * 32 + 8 * fq; const float sc = (u.pn < 4) ? QSCALE : 1.0f;
#pragma unroll
        for (int ai = 0; ai < 2; ++ai)
#pragma unroll
            for (int m = 0; m < 4; ++m) { bf16_t* rowp = O + (size_t)(row0 + ai * HALF + m * 16) * QKVW + col0;
#pragma unroll
                for (int bj = 0; bj < 2; ++bj) { const f32x4 v0 = acc[ai][bj][m][0] * sc, v1 = acc[ai][bj][m][1] * sc;
                    u32x4 w; w.x = pk2(v0[0], v0[1]); w.y = pk2(v0[2], v0[3]); w.z = pk2(v1[0], v1[1]); w.w = pk2(v1[2], v1[3]);
                    *(u32x4*)(rowp + bj * HALF) = w; } }
    }
};
struct EpiResF32 {
    static constexpr bool PERM = false; static constexpr int PROBE_ID = 3;
    const float* res; float* out; const float* scale;
    __device__ __forceinline__ void operator()(const f32x4 (&acc)[2][2][4][2], const Unit& u, int wr, int wc, int fr, int fq) const {
        const int row0 = u.pm * BM + wr * 64 + fr, col0 = u.pn * BM + wc * 32 + 4 * fq;
#pragma unroll
        for (int bj = 0; bj < 2; ++bj)
#pragma unroll
            for (int n = 0; n < 2; ++n) { const f32x4 sv = scale ? *(const f32x4*)(scale + col0 + bj * HALF + n * 16) : (f32x4){1.f, 1.f, 1.f, 1.f};
#pragma unroll
                for (int ai = 0; ai < 2; ++ai) {
#pragma unroll
                    for (int m = 0; m < 4; ++m) { const size_t off = (size_t)(row0 + ai * HALF + m * 16) * D + col0 + bj * HALF + n * 16;
                        const f32x4 r = *(const f32x4*)(res + off); *(f32x4*)(out + off) = r + acc[ai][bj][m][n] * sv; }
                    asm volatile("" ::: "memory"); } }
    }
};
__device__ __forceinline__ float silu_mul(float g, float u) { return g * u * __builtin_amdgcn_rcpf(1.0f + __builtin_amdgcn_exp2f(-g * LOG2E)); }
template <bool F8> struct EpiSwiGLU {
    static constexpr bool PERM = true; static constexpr int PROBE_ID = 5;
    unsigned char* O; int ldc, tile0;
    __device__ __forceinline__ void operator()(const f32x4 (&acc)[2][2][4][2], const Unit& u, int wr, int wc, int fr, int fq) const {
        const int row0 = (u.pm - tile0) * BM + wr * 64 + fr, col0 = u.pn * HALF + wc * 32 + 8 * fq;
#pragma unroll
        for (int ai = 0; ai < 2; ++ai)
#pragma unroll
            for (int m = 0; m < 4; ++m) { unsigned char* rowp = O + (size_t)(row0 + ai * HALF + m * 16) * ldc + col0 * (F8 ? 1 : 2);
                f32x4 g0 = acc[ai][0][m][0], g1 = acc[ai][0][m][1], u0 = acc[ai][1][m][0], u1 = acc[ai][1][m][1];
                if constexpr (F8) { g0 *= W8_INV; g1 *= W8_INV; u0 *= W8_INV; u1 *= W8_INV;
                    u32x2 w; w.x = pk4_fp8(silu_mul(g0[0], u0[0]), silu_mul(g0[1], u0[1]), silu_mul(g0[2], u0[2]), silu_mul(g0[3], u0[3]));
                    w.y = pk4_fp8(silu_mul(g1[0], u1[0]), silu_mul(g1[1], u1[1]), silu_mul(g1[2], u1[2]), silu_mul(g1[3], u1[3]));
                    *(u32x2*)rowp = w; }
                else { u32x4 w; w.x = pk2(silu_mul(g0[0], u0[0]), silu_mul(g0[1], u0[1])); w.y = pk2(silu_mul(g0[2], u0[2]), silu_mul(g0[3], u0[3]));
                    w.z = pk2(silu_mul(g1[0], u1[0]), silu_mul(g1[1], u1[1])); w.w = pk2(silu_mul(g1[2], u1[2]), silu_mul(g1[3], u1[3]));
                    *(u32x4*)rowp = w; } }
    }
};
struct EpiMoeDown {
    static constexpr bool PERM = true; static constexpr int PROBE_ID = 11;
    bf16_t* Y; const float* gsort; const volatile LAS int* tb;
    __device__ __forceinline__ void operator()(const f32x4 (&acc)[2][2][4][2], const Unit& u, int wr, int wc, int fr, int fq) const {
        const int lrow0 = wr * 64 + fr, col0 = u.pn * BM + wc * 32 + 8 * fq; const int p0 = (u.pm - __builtin_amdgcn_readfirstlane(tb[u.e])) * 256, n = __builtin_amdgcn_readfirstlane(tb[16 + u.e]);
#pragma unroll
        for (int ai = 0; ai < 2; ++ai)
#pragma unroll
            for (int m = 0; m < 4; ++m) { const int lr = lrow0 + ai * HALF + m * 16; const int pp = p0 + lr; const float gw = gsort[u.e * T + (pp < n ? pp : n - 1)] * W8_INV;
                bf16_t* rowp = Y + (size_t)(u.pm * 256 + lr) * D + col0;
#pragma unroll
                for (int bj = 0; bj < 2; ++bj) { const f32x4 v0 = acc[ai][bj][m][0] * gw, v1 = acc[ai][bj][m][1] * gw;
                    u32x4 w; w.x = pk2(v0[0], v0[1]); w.y = pk2(v0[2], v0[3]); w.z = pk2(v1[0], v1[1]); w.w = pk2(v1[2], v1[3]);
                    *(u32x4*)(rowp + bj * HALF) = w; } }
    }
};

template <class Epi, class Sched, bool GATHER, bool ALIGN_EPI, bool SP2, bool FP8>
__device__ __forceinline__ void gemm_phase(LAS unsigned char* lds, const Sched& S, const Epi& E, const int Kb, const int lda, const int ldb) {
    int tid_ = threadIdx.x; asm volatile("" : "+v"(tid_));
    const int tid = tid_, wid = __builtin_amdgcn_readfirstlane(tid >> 6), lane = tid & 63, wr = wid >> 2, wc = wid & 3, fr = lane & 15, fq = lane >> 4;
    int nt_ = Kb / 128; asm volatile("" : "+s"(nt_)); const int nt = nt_;
    unsigned voffA[2][2], voffB[2];
#pragma unroll
    for (int i = 0; i < 2; ++i) { int R, C; stage_rc(tid * 16 + i * 8192, R, C); const int Rb = Epi::PERM ? ((R & ~31) + perm32(R & 31)) : R;
        voffA[0][i] = (unsigned)(R * lda + 2 * C); voffA[1][i] = 0u; voffB[i] = (unsigned)(Rb * ldb + 2 * C); }
    const size_t kstep = (size_t)(BK * 2);
    const size_t hstepB = (size_t)HALF * ldb;
    const size_t hstepA = GATHER ? (size_t)0 : (size_t)HALF * lda;
    const unsigned ldsw = (unsigned)wid * 1024u;
    const int aoff = lds_byte(wr * 64 + fr, fq * 8), boff = lds_byte(wc * 32 + fr, fq * 8);
#define PG8_SA(b, h) (((b) * 2 + (h)) * HTB)
#define PG8_SB(b, h) ((4 + (b) * 2 + (h)) * HTB)
#define PG8_STAGE(bufoff, gbase, voff) do { _Pragma("unroll") for (int _i = 0; _i < 2; ++_i) \
        __builtin_amdgcn_global_load_lds((const unsigned*)((const char*)(gbase) + (voff)[_i]), (LAS unsigned*)(lds + (bufoff) + ldsw + _i * 8192), 16, 0, 0); } while (0)
#define PG8_LDA(dst, b, h) do { _Pragma("unroll") for (int m = 0; m < 4; ++m) { const LAS i32x4* _p = (const LAS i32x4*)(lds + PG8_SA(b, h) + aoff + m * 2048); const i32x4 _lo = _p[0], _hi = _p[64]; \
        dst[m] = __builtin_shufflevector(_lo, _hi, 0, 1, 2, 3, 4, 5, 6, 7); } } while (0)
#define PG8_LDB(dst, b, h) do { _Pragma("unroll") for (int n = 0; n < 2; ++n) { const LAS i32x4* _p = (const LAS i32x4*)(lds + PG8_SB(b, h) + boff + n * 2048); const i32x4 _lo = _p[0], _hi = _p[64]; \
        dst[n] = __builtin_shufflevector(_lo, _hi, 0, 1, 2, 3, 4, 5, 6, 7); } } while (0)
#define PG8_MMA(ai, bj, At, Bt) do { __builtin_amdgcn_s_setprio(1); _Pragma("unroll") for (int m = 0; m < 4; ++m) _Pragma("unroll") for (int n = 0; n < 2; ++n) { \
        if constexpr (FP8) { asm volatile("v_mfma_scale_f32_16x16x128_f8f6f4 %0, %1, %2, %0, %3, %3 op_sel_hi:[0,0,0]" : "+v"(acc[ai][bj][m][n]) : "v"(Bt[n]), "v"(At[m]), "v"(one8)); } \
        else { acc[ai][bj][m][n] = __builtin_amdgcn_mfma_f32_16x16x32_bf16(__builtin_bit_cast(bf16x8, __builtin_shufflevector(Bt[n], Bt[n], 0, 1, 2, 3)), __builtin_bit_cast(bf16x8, __builtin_shufflevector(At[m], At[m], 0, 1, 2, 3)), acc[ai][bj][m][n], 0, 0, 0); \
               acc[ai][bj][m][n] = __builtin_amdgcn_mfma_f32_16x16x32_bf16(__builtin_bit_cast(bf16x8, __builtin_shufflevector(Bt[n], Bt[n], 4, 5, 6, 7)), __builtin_bit_cast(bf16x8, __builtin_shufflevector(At[m], At[m], 4, 5, 6, 7)), acc[ai][bj][m][n], 0, 0, 0); } } \
        __builtin_amdgcn_s_setprio(0); } while (0)
#define PG8_WAIT_V(n) asm volatile("s_waitcnt vmcnt(" #n ")" ::: "memory")
#define PG8_WAIT_L(n) asm volatile("s_waitcnt lgkmcnt(" #n ")" ::: "memory")
#define PG8_BAR __builtin_amdgcn_s_barrier()
#define PG8_SCHED __builtin_amdgcn_sched_barrier(0)
#define PG8_GOFF(dst, unit) do { _Pragma("unroll") for (int _i = 0; _i < 2; ++_i) { int _R, _C; stage_rc(tid * 16 + _i * 8192, _R, _C); \
        dst[0][_i] = (unsigned)(S.grow(unit, _R) * lda + 2 * _C); dst[1][_i] = (unsigned)(S.grow(unit, _R + HALF) * lda + 2 * _C); } } while (0)
    Unit cur, nxt; int ui = 0;
    if (!S.next(0, cur)) return;
    f32x4 acc[2][2][4][2];
#pragma unroll
    for (int a = 0; a < 2; ++a)
#pragma unroll
        for (int b = 0; b < 2; ++b)
#pragma unroll
            for (int m = 0; m < 4; ++m)
#pragma unroll
                for (int n = 0; n < 2; ++n) acc[a][b][m][n] = (f32x4){0.f, 0.f, 0.f, 0.f};
    int one8 = 0x7F7F7F7F; asm volatile("" : "+v"(one8));
    i32x8 At[4], B0[2], B1[2];
    const char* cA = S.a_base(cur); const char* cB = S.b_base(cur);
    if constexpr (GATHER) { PG8_GOFF(voffA, cur); }
    if constexpr (SP2) {
        PG8_STAGE(PG8_SB(0, 0), cB, voffB); PG8_STAGE(PG8_SB(0, 1), cB + hstepB, voffB); PG8_STAGE(PG8_SA(0, 0), cA, voffA[0]); PG8_STAGE(PG8_SA(0, 1), cA + hstepA, voffA[GATHER ? 1 : 0]);
        if (wr == 1) PG8_BAR;
        PG8_WAIT_V(2); PG8_BAR;
        PG8_STAGE(PG8_SB(1, 0), cB + kstep, voffB); PG8_STAGE(PG8_SA(1, 0), cA + kstep, voffA[0]); PG8_STAGE(PG8_SB(1, 1), cB + hstepB + kstep, voffB);
        PG8_WAIT_V(6); PG8_BAR;
    } else {
        PG8_STAGE(PG8_SB(0, 0), cB, voffB); PG8_STAGE(PG8_SA(0, 0), cA, voffA[0]); PG8_STAGE(PG8_SB(0, 1), cB + hstepB, voffB); PG8_STAGE(PG8_SA(0, 1), cA + hstepA, voffA[GATHER ? 1 : 0]);
        if (wr == 1) PG8_BAR;
        PG8_WAIT_V(4); PG8_BAR;
        PG8_STAGE(PG8_SB(1, 0), cB + kstep, voffB); PG8_STAGE(PG8_SA(1, 0), cA + kstep, voffA[0]); PG8_STAGE(PG8_SB(1, 1), cB + hstepB + kstep, voffB);
        PG8_WAIT_V(6); PG8_BAR;
    }
    for (;;) {
        const bool has_next = S.next(ui + 1, nxt);
        const char* nA = has_next ? S.a_base(nxt) : cA; const char* nB = has_next ? S.b_base(nxt) : cB;
        for (int t = 0; t < nt; t += 2) {
            const bool last = (t == nt - 2);
            const char* a1 = cA + (size_t)(t + 1) * kstep;
            const char* a2 = last ? nA : cA + (size_t)(t + 2) * kstep; const char* b2 = last ? nB : cB + (size_t)(t + 2) * kstep;
            const char* a3 = a2 + kstep; const char* b3 = b2 + kstep;
            unsigned nv[2][2];
            if constexpr (GATHER) { if (last && has_next) { PG8_GOFF(nv, nxt); } }
            if constexpr (SP2) {
            PG8_LDB(B0, 0, 0); PG8_LDB(B1, 0, 1); PG8_SCHED; PG8_LDA(At, 0, 0); PG8_STAGE(PG8_SA(1, 1), a1 + hstepA, voffA[GATHER ? 1 : 0]);
            if constexpr (GATHER) { if (last && has_next) { voffA[0][0] = nv[0][0]; voffA[0][1] = nv[0][1]; voffA[1][0] = nv[1][0]; voffA[1][1] = nv[1][1]; } }
            PG8_WAIT_V(8); PG8_WAIT_L(0); PG8_BAR; PG8_MMA(0, 0, At, B0); PG8_MMA(0, 1, At, B1); PG8_BAR; PG8_SCHED;
            PG8_LDA(At, 0, 1); PG8_STAGE(PG8_SB(0, 0), b2, voffB); PG8_STAGE(PG8_SB(0, 1), b2 + hstepB, voffB); PG8_STAGE(PG8_SA(0, 0), a2, voffA[0]);
            PG8_WAIT_V(8); PG8_WAIT_L(0); PG8_BAR; PG8_MMA(1, 0, At, B0); PG8_MMA(1, 1, At, B1); PG8_BAR; PG8_SCHED;
            PG8_LDB(B0, 1, 0); PG8_LDB(B1, 1, 1); PG8_SCHED; PG8_LDA(At, 1, 0); PG8_STAGE(PG8_SA(0, 1), a2 + hstepA, voffA[GATHER ? 1 : 0]);
            PG8_WAIT_V(8); PG8_WAIT_L(0); PG8_BAR; PG8_MMA(0, 0, At, B0); PG8_MMA(0, 1, At, B1); PG8_BAR; PG8_SCHED;
            PG8_LDA(At, 1, 1); PG8_STAGE(PG8_SB(1, 0), b3, voffB); PG8_STAGE(PG8_SB(1, 1), b3 + hstepB, voffB); PG8_STAGE(PG8_SA(1, 0), a3, voffA[0]);
            PG8_WAIT_V(8); PG8_WAIT_L(0); PG8_BAR; PG8_MMA(1, 0, At, B0); PG8_MMA(1, 1, At, B1); PG8_BAR; PG8_SCHED;
            } else {
            PG8_LDB(B0, 0, 0); PG8_SCHED; PG8_LDA(At, 0, 0); PG8_STAGE(PG8_SA(1, 1), a1 + hstepA, voffA[GATHER ? 1 : 0]);
            if constexpr (GATHER) { if (last && has_next) { voffA[0][0] = nv[0][0]; voffA[0][1] = nv[0][1]; voffA[1][0] = nv[1][0]; voffA[1][1] = nv[1][1]; } }
            PG8_WAIT_L(8); PG8_BAR; PG8_WAIT_L(0); PG8_MMA(0, 0, At, B0); PG8_BAR; PG8_SCHED;
            PG8_LDB(B1, 0, 1); PG8_STAGE(PG8_SB(0, 0), b2, voffB);
            PG8_BAR; PG8_WAIT_L(0); PG8_MMA(0, 1, At, B1); PG8_BAR;
            PG8_LDA(At, 0, 1); PG8_STAGE(PG8_SA(0, 0), a2, voffA[0]);
            PG8_BAR; PG8_WAIT_L(0); PG8_MMA(1, 0, At, B0); PG8_BAR; PG8_SCHED;
            PG8_STAGE(PG8_SB(0, 1), b2 + hstepB, voffB);
            PG8_WAIT_V(6); PG8_BAR; PG8_MMA(1, 1, At, B1); PG8_BAR;
            PG8_LDB(B0, 1, 0); PG8_SCHED; PG8_LDA(At, 1, 0); PG8_STAGE(PG8_SA(0, 1), a2 + hstepA, voffA[GATHER ? 1 : 0]);
            PG8_WAIT_L(8); PG8_BAR; PG8_WAIT_L(0); PG8_MMA(0, 0, At, B0); PG8_BAR; PG8_SCHED;
            PG8_LDB(B1, 1, 1); PG8_STAGE(PG8_SB(1, 0), b3, voffB);
            PG8_BAR; PG8_WAIT_L(0); PG8_MMA(0, 1, At, B1); PG8_BAR;
            PG8_LDA(At, 1, 1); PG8_STAGE(PG8_SA(1, 0), a3, voffA[0]);
            PG8_BAR; PG8_WAIT_L(0); PG8_MMA(1, 0, At, B0); PG8_BAR; PG8_SCHED;
            PG8_STAGE(PG8_SB(1, 1), b3 + hstepB, voffB);
            PG8_WAIT_V(6); PG8_BAR; PG8_MMA(1, 1, At, B1); PG8_BAR;
            }
        }
        if constexpr (FP8) {
            asm volatile("s_nop 15\n\ts_nop 7" ::: "memory");
#pragma unroll
            for (int a = 0; a < 2; ++a)
#pragma unroll
                for (int b = 0; b < 2; ++b) asm volatile("" : "+v"(acc[a][b][0][0]), "+v"(acc[a][b][0][1]), "+v"(acc[a][b][1][0]), "+v"(acc[a][b][1][1]), "+v"(acc[a][b][2][0]), "+v"(acc[a][b][2][1]), "+v"(acc[a][b][3][0]), "+v"(acc[a][b][3][1]));
        }
        if constexpr (ALIGN_EPI) { if (wr == 0) PG8_BAR; }
        E(acc, cur, wr, wc, fr, fq);
#if PROBE_REPEAT == 105
        if constexpr (Epi::PROBE_ID == 5) { asm volatile("s_waitcnt vmcnt(0)" ::: "memory"); E(acc, cur, wr, wc, fr, fq); }
#endif
        if (!has_next) break;
#pragma unroll
        for (int a = 0; a < 2; ++a)
#pragma unroll
            for (int b = 0; b < 2; ++b)
#pragma unroll
                for (int m = 0; m < 4; ++m)
#pragma unroll
                    for (int n = 0; n < 2; ++n) acc[a][b][m][n] = (f32x4){0.f, 0.f, 0.f, 0.f};
        cur = nxt; cA = nA; cB = nB; ++ui;
        if constexpr (FP8) asm volatile("s_nop 3" ::: "memory");
        if constexpr (ALIGN_EPI) { if (wr == 1) PG8_BAR; }
    }
    PG8_WAIT_V(0);
    if constexpr (!ALIGN_EPI) { if (wr == 0) PG8_BAR; }
    PG8_BAR;
#undef PG8_SA
#undef PG8_SB
#undef PG8_STAGE
#undef PG8_LDA
#undef PG8_LDB
#undef PG8_MMA
#undef PG8_WAIT_V
#undef PG8_WAIT_L
#undef PG8_BAR
#undef PG8_SCHED
#undef PG8_GOFF
}
}

__device__ __forceinline__ void transpose_item(const float* W, int N, bf16_t* WT, int K, int k0, int n0, int drow0, LAS float* scr, int lane) {
#pragma unroll 8
    for (int kk = 0; kk < 64; ++kk) scr[kk * 65 + lane] = W[(size_t)(k0 + kk) * N + n0 + lane];
    LDS_WAIT(); asm volatile("" ::: "memory");
    const int c = lane & 7;
#pragma unroll
    for (int j = 0; j < 8; ++j) { const int n = (lane >> 3) + 8 * j; const LAS float* s = scr + (8 * c) * 65 + n;
        u32x4 o; o.x = pk2(s[0 * 65], s[1 * 65]); o.y = pk2(s[2 * 65], s[3 * 65]); o.z = pk2(s[4 * 65], s[5 * 65]); o.w = pk2(s[6 * 65], s[7 * 65]);
        *(u32x4*)(WT + (size_t)(drow0 + n) * K + k0 + 8 * c) = o; }
    LDS_WAIT(); asm volatile("" ::: "memory");
}
__device__ __forceinline__ void transpose_item8(const float* W, int N, unsigned char* WT, int K, int k0, int n0, int drow0, LAS float* scr, int lane) {
#pragma unroll 8
    for (int kk = 0; kk < 64; ++kk) scr[kk * 65 + lane] = W[(size_t)(k0 + kk) * N + n0 + lane];
    LDS_WAIT(); asm volatile("" ::: "memory");
    const int c = lane & 3;
#pragma unroll
    for (int j = 0; j < 4; ++j) { const int n = (lane >> 2) + 16 * j; const LAS float* s = scr + (16 * c) * 65 + n;
        u32x4 o; o.x = pk4_fp8(s[0 * 65] * W8_SCALE, s[1 * 65] * W8_SCALE, s[2 * 65] * W8_SCALE, s[3 * 65] * W8_SCALE); o.y = pk4_fp8(s[4 * 65] * W8_SCALE, s[5 * 65] * W8_SCALE, s[6 * 65] * W8_SCALE, s[7 * 65] * W8_SCALE);
        o.z = pk4_fp8(s[8 * 65] * W8_SCALE, s[9 * 65] * W8_SCALE, s[10 * 65] * W8_SCALE, s[11 * 65] * W8_SCALE); o.w = pk4_fp8(s[12 * 65] * W8_SCALE, s[13 * 65] * W8_SCALE, s[14 * 65] * W8_SCALE, s[15 * 65] * W8_SCALE);
        *(u32x4*)(WT + (size_t)(drow0 + n) * K + k0 + 16 * c) = o; }
    LDS_WAIT(); asm volatile("" ::: "memory");
}
template <bool F8> __device__ __forceinline__ bool transpose_matrix(int& it, const float* W, int K, int N, void* WT, int inter, int ioff, LAS float* scr, int lane) {
    const int nnb = N / 64, items = (K / 64) * nnb;
    if (it >= items) { it -= items; return false; }
    const int kb = it / nnb, nb = it % nnb, n0 = nb * 64;
    const int drow0 = inter ? ((n0 >> 7) * 256 + ioff + (n0 & 127)) : n0;
    if constexpr (F8) transpose_item8(W, N, (unsigned char*)WT, K, kb * 64, n0, drow0, scr, lane); else transpose_item(W, N, (bf16_t*)WT, K, kb * 64, n0, drow0, scr, lane);
    return true;
}
__device__ __forceinline__ void rms_row_to_bf16(const float* xrow, const f32x4 (&gn)[4], bf16_t* orow, int lane) {
    const f32x4* xr = (const f32x4*)xrow + lane;
    f32x4 v[4]; float s = 0.f;
#pragma unroll
    for (int j = 0; j < 4; ++j) { v[j] = xr[64 * j]; s += (v[j].x * v[j].x + v[j].y * v[j].y) + (v[j].z * v[j].z + v[j].w * v[j].w); }
    const float rstd = 1.0f / sqrtf(wave_sum(s) * (1.f / D) + RMS_EPS);
    u32x2* o8 = (u32x2*)orow + lane;
#pragma unroll
    for (int j = 0; j < 4; ++j) { const f32x4 y = v[j] * rstd * gn[j]; u32x2 w; w.x = pk2(y.x, y.y); w.y = pk2(y.z, y.w); o8[64 * j] = w; }
}
__device__ __forceinline__ void rms_phase(const float* X, const float* gain, bf16_t* O, int gw, int ngw, int lane) {
    f32x4 gn[4];
#pragma unroll
    for (int j = 0; j < 4; ++j) gn[j] = ((const f32x4*)gain)[lane + 64 * j];
    for (int m = gw; m < T; m += ngw) rms_row_to_bf16(X + (size_t)m * D, gn, O + (size_t)m * D, lane);
}

__device__ __forceinline__ unsigned ks_off(int key, int c) { return (unsigned)(key * 128 + ((c ^ ((key >> 1) & 7)) << 4)); }
__device__ __forceinline__ unsigned vs_off(int key, int c) { return (unsigned)(key * 128 + ((c ^ (((key >> 1) & 1) << 2)) << 4)); }
template <int OFF> __device__ __forceinline__ void tr_read4(s16x4& a, s16x4& b, s16x4& c, s16x4& d, unsigned b0, unsigned b1) {
    asm volatile("ds_read_b64_tr_b16 %0, %4 offset:%6\n\tds_read_b64_tr_b16 %1, %4 offset:%7\n\tds_read_b64_tr_b16 %2, %5 offset:%6\n\tds_read_b64_tr_b16 %3, %5 offset:%7\n\ts_waitcnt lgkmcnt(0)"
                 : "=&v"(a), "=&v"(b), "=&v"(c), "=&v"(d) : "v"(b0), "v"(b1), "i"(OFF), "i"(OFF + 1024) : "memory");
}
__device__ __forceinline__ void attn_phase(LAS unsigned char* lds, const bf16_t* QKV, bf16_t* O, const float* sinks, int G, int bid) {
    const int tid = threadIdx.x, lane = tid & 63, wid = __builtin_amdgcn_readfirstlane(tid >> 6);
    const int g = wid >> 1, half = wid & 1, ql = lane & 31, h = lane >> 5;
    LAS unsigned char* Ks = lds; LAS unsigned char* Vs = lds + 32768;
    const int i16 = lane & 15, tq = i16 >> 2, tp = i16 & 3, blk = (lane >> 4) & 1;
    for (int u = bid; u < BATCH * 32 * NKV; u += G) {
        const int kvh = u & 3, bn = u >> 2, n = bn & 31, b = bn >> 5;
        const int tok0 = b * SEQ + n * 128;
        __syncthreads();
#pragma unroll
        for (int i = 0; i < 4; ++i) { const int q = tid + 512 * i, row = q >> 3, c = q & 7; const bool valid = (n > 0) || (row >= 128);
            u32x4 kv = (u32x4){0u, 0u, 0u, 0u}, vv = (u32x4){0u, 0u, 0u, 0u};
            if (valid) { const bf16_t* p = QKV + (size_t)(tok0 - 128 + row) * QKVW + 1024 + kvh * 64 + c * 8; kv = *(const u32x4*)p; vv = *(const u32x4*)(p + 256); }
            *(LAS u32x4*)(Ks + ks_off(row, c)) = kv; *(LAS u32x4*)(Vs + vs_off(row, c)) = vv; }
        __syncthreads();
        const int hq = kvh * 4 + g;
        const float slope2 = __builtin_amdgcn_exp2f(-0.5f * (float)(hq + 1)) * LOG2E, sink2 = sinks[hq] * LOG2E;
#pragma unroll 1
        for (int sub = 0; sub < 2; ++sub) {
            const int r0 = half * 64 + sub * 32, c0 = r0 >> 5, r = r0 + ql;
            const bf16_t* qp = QKV + (size_t)(tok0 + r) * QKVW + hq * 64 + 8 * h;
            bf16x8 qf[4];
#pragma unroll
            for (int kk = 0; kk < 4; ++kk) qf[kk] = *(const bf16x8*)(qp + 16 * kk);
            const LAS unsigned char* kb0 = Ks + c0 * 4096 + ks_off(ql, 0 + h); const LAS unsigned char* kb1 = Ks + c0 * 4096 + ks_off(ql, 2 + h);
            const LAS unsigned char* kb2 = Ks + c0 * 4096 + ks_off(ql, 4 + h); const LAS unsigned char* kb3 = Ks + c0 * 4096 + ks_off(ql, 6 + h);
            f32x16 S[5];
#pragma unroll
            for (int ck = 0; ck < 5; ++ck) {
#pragma unroll
                for (int i = 0; i < 16; ++i) S[ck][i] = 0.f;
                S[ck] = __builtin_amdgcn_mfma_f32_32x32x16_bf16(*(const LAS bf16x8*)(kb0 + 4096 * ck), qf[0], S[ck], 0, 0, 0);
                S[ck] = __builtin_amdgcn_mfma_f32_32x32x16_bf16(*(const LAS bf16x8*)(kb1 + 4096 * ck), qf[1], S[ck], 0, 0, 0);
                S[ck] = __builtin_amdgcn_mfma_f32_32x32x16_bf16(*(const LAS bf16x8*)(kb2 + 4096 * ck), qf[2], S[ck], 0, 0, 0);
                S[ck] = __builtin_amdgcn_mfma_f32_32x32x16_bf16(*(const LAS bf16x8*)(kb3 + 4096 * ck), qf[3], S[ck], 0, 0, 0);
            }
            const int bd = 128 + ql - 4 * h, jb = 32 * c0 + 4 * h; const float nb = -slope2 * (float)bd;
            float mx = sink2;
#pragma unroll
            for (int ck = 0; ck < 5; ++ck)
#pragma unroll
                for (int i = 0; i < 16; ++i) { const int kc = 32 * ck + (i & 3) + 8 * (i >> 2);
                    const bool valid = (kc <= bd) && (kc > bd - 128) && ((n > 0) || (jb + kc >= 128));
                    const float s = valid ? (S[ck][i] + nb + slope2 * (float)kc) : -1e30f; S[ck][i] = s; mx = fmaxf(mx, s); }
            mx = fmaxf(mx, __shfl_xor(mx, 32));
            float l = 0.f;
            bf16x8 pf[5][2];
#pragma unroll
            for (int ck = 0; ck < 5; ++ck)
#pragma unroll
                for (int s = 0; s < 2; ++s) { float p[8];
#pragma unroll
                    for (int i = 0; i < 8; ++i) { p[i] = __builtin_amdgcn_exp2f(S[ck][8 * s + i] - mx); l += p[i]; }
                    u32x4 pw; pw.x = pk2(p[0], p[1]); pw.y = pk2(p[2], p[3]); pw.z = pk2(p[4], p[5]); pw.w = pk2(p[6], p[7]);
                    pf[ck][s] = __builtin_bit_cast(bf16x8, pw); }
            l += __shfl_xor(l, 32); l += __builtin_amdgcn_exp2f(sink2 - mx);
            const float inv = 1.0f / l;
            f32x16 o0, o1;
#pragma unroll
            for (int i = 0; i < 16; ++i) { o0[i] = 0.f; o1[i] = 0.f; }
            const unsigned vb0 = (unsigned)(size_t)Vs + c0 * 4096 + vs_off(4 * h + tq, 2 * blk + (tp >> 1)) + 8 * (tp & 1);
            const unsigned vb1 = (unsigned)(size_t)Vs + c0 * 4096 + vs_off(4 * h + tq, 4 + 2 * blk + (tp >> 1)) + 8 * (tp & 1);
#define ATT_PV(ck, s) do { s16x4 lo0, hi0, lo1, hi1; tr_read4<4096 * (ck) + 2048 * (s)>(lo0, hi0, lo1, hi1, vb0, vb1); \
                const bf16x8 v0 = __builtin_shufflevector(lo0, hi0, 0, 1, 2, 3, 4, 5, 6, 7), v1 = __builtin_shufflevector(lo1, hi1, 0, 1, 2, 3, 4, 5, 6, 7); \
                o0 = __builtin_amdgcn_mfma_f32_32x32x16_bf16(v0, pf[ck][s], o0, 0, 0, 0); o1 = __builtin_amdgcn_mfma_f32_32x32x16_bf16(v1, pf[ck][s], o1, 0, 0, 0); } while (0)
            ATT_PV(0, 0); ATT_PV(0, 1); ATT_PV(1, 0); ATT_PV(1, 1); ATT_PV(2, 0); ATT_PV(2, 1); ATT_PV(3, 0); ATT_PV(3, 1); ATT_PV(4, 0); ATT_PV(4, 1);
#undef ATT_PV
            bf16_t* op = O + (size_t)(tok0 + r) * D + hq * 64 + 4 * h;
#pragma unroll
            for (int g4 = 0; g4 < 4; ++g4) {
                u32x2 w0; w0.x = pk2(o0[4 * g4 + 0] * inv, o0[4 * g4 + 1] * inv); w0.y = pk2(o0[4 * g4 + 2] * inv, o0[4 * g4 + 3] * inv);
                u32x2 w1; w1.x = pk2(o1[4 * g4 + 0] * inv, o1[4 * g4 + 1] * inv); w1.y = pk2(o1[4 * g4 + 2] * inv, o1[4 * g4 + 3] * inv);
                *(u32x2*)(op + 8 * g4) = w0; *(u32x2*)(op + 32 + 8 * g4) = w1; }
        }
    }
}

__device__ __forceinline__ void pool_phase(LAS unsigned char* lds, const float* X, const float* gain, bf16_t* P, int G, int bid) {
    const int tid = threadIdx.x, lane = tid & 63, wid = __builtin_amdgcn_readfirstlane(tid >> 6);
    LAS float* rs = (LAS float*)lds;
    const int c = 2 * tid, w = 2 << (tid >> 7);
    const f32x2 gn = *(const f32x2*)(gain + c);
    for (int ch = bid; ch < T / 128; ch += G) {
        const int row0 = ch * 128, spos0 = row0 & (SEQ - 1), halo = spos0 ? 15 : 0;
        __syncthreads();
        for (int i = -halo + wid; i < 128; i += 8) { const f32x4* xr = (const f32x4*)(X + (size_t)(row0 + i) * D) + lane; float s = 0.f;
#pragma unroll
            for (int j = 0; j < 4; ++j) { const f32x4 v = xr[64 * j]; s += (v.x * v.x + v.y * v.y) + (v.z * v.z + v.w * v.w); }
            s = wave_sum(s); if (lane == 0) rs[i + 15] = 1.0f / sqrtf(s * (1.f / D) + RMS_EPS); }
        __syncthreads();
        const int istart = halo ? -(w - 1) : 0;
        f32x2 S = (f32x2){0.f, 0.f};
        for (int i = istart; i < 128; ++i) {
            const f32x2 v = *(const f32x2*)(X + (size_t)(row0 + i) * D + c) * rs[i + 15] * gn;
            S += v;
            if (i - w >= istart) { const f32x2 vo = *(const f32x2*)(X + (size_t)(row0 + i - w) * D + c) * rs[i - w + 15] * gn; S -= vo; }
            if (i >= 0) { const int pos = spos0 + i + 1; const float cnt = (float)(pos < w ? pos : w); const f32x2 pv = S / cnt - v;
                *(unsigned*)(P + (size_t)(row0 + i) * D + c) = pk2(pv.x, pv.y); }
        }
    }
}

__device__ __forceinline__ void router_phase(LAS unsigned char* lds, volatile LAS unsigned* MISC, const float* X, const float* gain, const float* wr, bf16_t* H,
                                             unsigned* gcnt, int* list, float* gsort, int* tokinfo, int G, int bid) {
    const int tid = threadIdx.x, lane = tid & 63, wid = __builtin_amdgcn_readfirstlane(tid >> 6);
    LAS float* wl = (LAS float*)lds;
    __syncthreads();
    for (int i = tid; i < D * NE / 4; i += 512) ((LAS f32x4*)wl)[i] = ((const f32x4*)wr)[i];
    f32x4 gn[4];
#pragma unroll
    for (int j = 0; j < 4; ++j) gn[j] = ((const f32x4*)gain)[lane + 64 * j];
    volatile LAS unsigned* lcnt = MISC + 32; volatile LAS unsigned* lbase = MISC + 40;
    for (int ch = bid; ch < T / 128; ch += G) {
        if (tid < 8) lcnt[tid] = 0u;
        __syncthreads();
        int me1 = 0, me2 = 0; float mg1 = 0.f, mg2 = 0.f;
        for (int i = 0; i < 16; ++i) {
            const int t = ch * 128 + wid * 16 + i;
            const f32x4* xr = (const f32x4*)(X + (size_t)t * D) + lane;
            f32x4 v[4]; float s = 0.f;
#pragma unroll
            for (int j = 0; j < 4; ++j) { v[j] = xr[64 * j]; s += (v[j].x * v[j].x + v[j].y * v[j].y) + (v[j].z * v[j].z + v[j].w * v[j].w); }
            const float rstd = 1.0f / sqrtf(wave_sum(s) * (1.f / D) + RMS_EPS);
            float lg[8];
#pragma unroll
            for (int e = 0; e < 8; ++e) lg[e] = 0.f;
            unsigned* o8 = (unsigned*)((unsigned char*)H + (size_t)t * D) + lane;
#pragma unroll
            for (int j = 0; j < 4; ++j) { const f32x4 y = v[j] * rstd * gn[j]; o8[64 * j] = pk4_fp8(y.x, y.y, y.z, y.w);
#pragma unroll
                for (int q = 0; q < 4; ++q) { const LAS f32x4* wp = (const LAS f32x4*)(wl + (size_t)(4 * lane + 256 * j + q) * 8); const f32x4 wa = wp[0], wb = wp[1]; const float yq = y[q];
                    lg[0] += yq * wa.x; lg[1] += yq * wa.y; lg[2] += yq * wa.z; lg[3] += yq * wa.w; lg[4] += yq * wb.x; lg[5] += yq * wb.y; lg[6] += yq * wb.z; lg[7] += yq * wb.w; } }
#pragma unroll
            for (int e = 0; e < 8; ++e) lg[e] = wave_sum(lg[e]);
            int e1 = 0; float v1 = lg[0];
#pragma unroll
            for (int e = 1; e < 8; ++e) if (lg[e] > v1) { v1 = lg[e]; e1 = e; }
            int e2 = -1; float v2 = -3.0e38f;
#pragma unroll
            for (int e = 0; e < 8; ++e) if (e != e1 && lg[e] > v2) { v2 = lg[e]; e2 = e; }
            const float g2 = 1.0f / (1.0f + __expf(v1 - v2)), g1 = 1.0f - g2;
            if (lane == i) { me1 = e1; me2 = e2; mg1 = g1; mg2 = g2; }
        }
        unsigned lp1 = 0, lp2 = 0;
        if (lane < 16) { lp1 = atomicAdd((unsigned*)(MISC + 32 + me1), 1u); lp2 = atomicAdd((unsigned*)(MISC + 32 + me2), 1u); }
        __syncthreads();
        if (tid < 8) lbase[tid] = __hip_atomic_fetch_add(gcnt + 64 * tid, lcnt[tid], RLX_AGENT);
        __syncthreads();
        if (lane < 16) { const int t = ch * 128 + wid * 16 + lane; const int p1 = (int)(lbase[me1] + lp1), p2 = (int)(lbase[me2] + lp2);
            list[me1 * T + p1] = t; gsort[me1 * T + p1] = mg1; list[me2 * T + p2] = t; gsort[me2 * T + p2] = mg2;
            tokinfo[2 * t] = (me1 << 20) | p1; tokinfo[2 * t + 1] = (me2 << 20) | p2; }
        __syncthreads();
    }
}
__device__ __forceinline__ void moe_tiles(volatile LAS int* tb, unsigned* gcnt) {
    __syncthreads();
    if (threadIdx.x == 0) { int a = 0;
        for (int e = 0; e < 8; ++e) { const int c = (int)__hip_atomic_load(gcnt + 64 * e, RLX_AGENT); tb[e] = a; tb[16 + e] = c; a += (c + 255) >> 8; }
        tb[8] = a; }
    __syncthreads();
}
__device__ __forceinline__ void combine_phase(volatile LAS int* tb, float* X, const bf16_t* Y, const int* tokinfo, const float* gain, int gw, int ngw, int lane) {
    f32x4 gn[4];
#pragma unroll
    for (int j = 0; j < 4; ++j) gn[j] = ((const f32x4*)gain)[lane + 64 * j];
    for (int t = gw; t < T; t += ngw) {
        const int i0 = tokinfo[2 * t], i1 = tokinfo[2 * t + 1];
        const int s0 = tb[i0 >> 20] * 256 + (i0 & 0xFFFFF), s1 = tb[i1 >> 20] * 256 + (i1 & 0xFFFFF);
        f32x4* xr = (f32x4*)(X + (size_t)t * D) + lane; const u32x2* y0 = (const u32x2*)(Y + (size_t)s0 * D) + lane; const u32x2* y1 = (const u32x2*)(Y + (size_t)s1 * D) + lane;
        f32x4 v[4]; float s = 0.f;
#pragma unroll
        for (int j = 0; j < 4; ++j) { const u32x2 a = y0[64 * j], b = y1[64 * j]; f32x4 x = xr[64 * j];
            x.x += __uint_as_float(a.x << 16) + __uint_as_float(b.x << 16); x.y += __uint_as_float(a.x & 0xFFFF0000u) + __uint_as_float(b.x & 0xFFFF0000u);
            x.z += __uint_as_float(a.y << 16) + __uint_as_float(b.y << 16); x.w += __uint_as_float(a.y & 0xFFFF0000u) + __uint_as_float(b.y & 0xFFFF0000u);
            v[j] = x; s += (x.x * x.x + x.y * x.y) + (x.z * x.z + x.w * x.w); }
        const float rstd = 1.0f / sqrtf(wave_sum(s) * (1.f / D) + RMS_EPS);
#pragma unroll
        for (int j = 0; j < 4; ++j) xr[64 * j] = v[j] * rstd * gn[j];
    }
}

constexpr int NPHASE = 10 + 2 * NPASS + 1;
struct Args { const float* in[18]; float* out; unsigned char* ws; int ph_lo, ph_hi; };
__global__ void __launch_bounds__(512, 2) trunk_fwd(Args args) {
    extern __shared__ __attribute__((aligned(16))) unsigned char lds_raw[];
    LAS unsigned char* lds = (LAS unsigned char*)lds_raw;
    volatile LAS unsigned* MISC = (volatile LAS unsigned*)(lds + MISC_OFF);
    const int tid = threadIdx.x, lane = tid & 63, wave = __builtin_amdgcn_readfirstlane(tid >> 6);
    const int G = gridDim.x, bid = blockIdx.x;
    const int gw = bid * 8 + wave, ngw = G * 8;
    unsigned char* ws = args.ws;
    unsigned* ctl = (unsigned*)(ws + WS_CTL);
    for (int u = tid; u < (LDS_BYTES - MISC_OFF) / 4; u += 512) MISC[u] = 0u;
    __syncthreads();
#if MK_PER_PHASE
#define GRID_BAR() do { } while (0)
#else
    XcdBarrier bar = xcd_barrier_post(ctl + CW_BAR, MISC);
#define GRID_BAR() xcd_barrier(bar)
#endif
    const float* x_in = args.in[0]; float* out = args.out;
    bf16_t* Wqkv = (bf16_t*)(ws + WS_WQKV); bf16_t* Wo = (bf16_t*)(ws + WS_WO); bf16_t* Wgu = (bf16_t*)(ws + WS_WGU); bf16_t* Wd = (bf16_t*)(ws + WS_WD); bf16_t* Wp = (bf16_t*)(ws + WS_WP);
    unsigned char* Mgu = ws + WS_MGU; unsigned char* Md = ws + WS_MD;
    bf16_t* HB = (bf16_t*)(ws + WS_HB); bf16_t* QKV = (bf16_t*)(ws + WS_B); bf16_t* ACT = (bf16_t*)(ws + WS_B); bf16_t* Yb = (bf16_t*)(ws + WS_Y); unsigned char* MACT = ws + WS_MACT;
    int* list = (int*)(ws + WS_LIST); float* gsort = (float*)(ws + WS_GSORT); int* tokinfo = (int*)(ws + WS_TOKINFO);
    unsigned* gcnt = ctl + CW_CNT;
    volatile LAS int* tb = (volatile LAS int*)(MISC + 8);
    const int lo = args.ph_lo, hi = args.ph_hi;
#ifndef PHMASK
#define PHMASK 0xFFFFFFFFu
#endif
#define IN(k) ((((PHMASK) >> ((k) < 10 ? (k) : (10 + (((k) - 10) & 1)))) & 1u) && lo <= (k) && (k) < hi)
#define SEAM(k) do { if (IN(k) && IN((k) + 1)) GRID_BAR(); } while (0)

    for (int rep = 0; rep < REPS(0); ++rep) { if (rep) GRID_BAR(); if (IN(0)) {
        LAS float* scr = (LAS float*)(lds + wave * 16640);
        constexpr int I_QKV = 16 * 24, I_O = 16 * 16, I_G = 16 * 44, I_D = 44 * 16, I_P = 4 * 16, I_MG = 16 * 56, I_MD = 56 * 16;
        constexpr int NITEMS = I_QKV + I_O + 2 * I_G + I_D + I_P + NE * (2 * I_MG + I_MD);
        for (int item = gw; item < NITEMS; item += ngw) {
            int it = item;
            if (transpose_matrix<false>(it, args.in[2], D, QKVW, Wqkv, 0, 0, scr, lane)) continue;
            if (transpose_matrix<false>(it, args.in[4], D, D, Wo, 0, 0, scr, lane)) continue;
            if (transpose_matrix<false>(it, args.in[6], D, DFF, Wgu, 1, 0, scr, lane)) continue;
            if (transpose_matrix<false>(it, args.in[7], D, DFF, Wgu, 1, 128, scr, lane)) continue;
            if (transpose_matrix<false>(it, args.in[8], DFF, D, Wd, 0, 0, scr, lane)) continue;
            if (it < I_P) { const int g = it / 16; int r = it % 16; transpose_matrix<false>(r, args.in[10] + (size_t)g * 256 * 256, 256, 256, Wp + (size_t)g * 256 * 256, 0, 0, scr, lane); continue; }
            it -= I_P;
            { const int per = 2 * I_MG + I_MD, e = it / per; int r = it % per;
              if (transpose_matrix<true>(r, args.in[14] + (size_t)e * D * DFE, D, DFE, Mgu + (size_t)e * 2 * DFE * D, 1, 0, scr, lane)) continue;
              if (transpose_matrix<true>(r, args.in[15] + (size_t)e * D * DFE, D, DFE, Mgu + (size_t)e * 2 * DFE * D, 1, 128, scr, lane)) continue;
              transpose_matrix<true>(r, args.in[16] + (size_t)e * DFE * D, DFE, D, Md + (size_t)e * D * DFE, 0, 0, scr, lane); }
        }
        rms_phase(x_in, args.in[1], HB, gw, ngw, lane);
    }
    }
    SEAM(0);
    for (int rep = 0; rep < REPS(1); ++rep) { if (rep) GRID_BAR(); if (IN(1)) {
        pg8::DenseOrder S{(const char*)HB, (const char*)Wqkv, 2 * D, 2 * D, T / 256, QKVW / 256, G, bid, 0}; pg8::EpiQKV E{QKV};
        pg8::gemm_phase<pg8::EpiQKV, pg8::DenseOrder, false, true, true, false>(lds, S, E, 2 * D, 2 * D, 2 * D);
    }
    }
    SEAM(1);
    for (int rep = 0; rep < REPS(2); ++rep) { if (rep) GRID_BAR(); if (IN(2)) attn_phase(lds, QKV, HB, args.in[3], G, bid);
    }
    SEAM(2);
    for (int rep = 0; rep < REPS(3); ++rep) { if (rep) GRID_BAR(); if (IN(3)) {
        pg8::DenseOrder S{(const char*)HB, (const char*)Wo, 2 * D, 2 * D, T / 256, D / 256, G, bid, 0}; pg8::EpiResF32 E{x_in, out, nullptr};
        pg8::gemm_phase<pg8::EpiResF32, pg8::DenseOrder, false, true, true, false>(lds, S, E, 2 * D, 2 * D, 2 * D);
    }
    }
    SEAM(3);
    for (int rep = 0; rep < REPS(4); ++rep) { if (rep) GRID_BAR(); if (IN(4)) rms_phase(out, args.in[5], HB, gw, ngw, lane);
    }
    SEAM(4);
    for (int rep = 0; rep < REPS(5); ++rep) { if (rep) GRID_BAR(); if (IN(5)) {
        pg8::DenseOrder S{(const char*)HB, (const char*)Wgu, 2 * D, 2 * D, T / 256, 2 * DFF / 256, G, bid, 0}; pg8::EpiSwiGLU<false> E{(unsigned char*)ACT, 2 * DFF, 0};
        pg8::gemm_phase<pg8::EpiSwiGLU<false>, pg8::DenseOrder, false, true, true, false>(lds, S, E, 2 * D, 2 * D, 2 * D);
    }
    }
    SEAM(5);
    if (IN(6)) {
        pg8::DenseOrder S{(const char*)ACT, (const char*)Wd, 2 * DFF, 2 * DFF, T / 256, D / 256, G, bid, 0}; pg8::EpiResF32 E{out, out, nullptr};
        pg8::gemm_phase<pg8::EpiResF32, pg8::DenseOrder, false, true, true, false>(lds, S, E, 2 * DFF, 2 * DFF, 2 * DFF);
    }
    SEAM(6);
    for (int rep = 0; rep < REPS(7); ++rep) { if (rep) GRID_BAR(); if (IN(7)) pool_phase(lds, out, args.in[9], HB, G, bid);
    }
    SEAM(7);
    if (IN(8)) {
        pg8::DenseOrder S{(const char*)HB, (const char*)Wp, 2 * D, 512, T / 256, 4, G, bid, 1}; pg8::EpiResF32 E{out, out, args.in[11]};
        pg8::gemm_phase<pg8::EpiResF32, pg8::DenseOrder, false, true, true, false>(lds, S, E, 512, 2 * D, 512);
    }
    SEAM(8);
    if (IN(9)) router_phase(lds, MISC, out, args.in[12], args.in[13], HB, gcnt, list, gsort, tokinfo, G, bid);
    SEAM(9);
    if (hi > 10) moe_tiles(tb, gcnt);
    {
        const int Gt = tb[8], TP = (Gt + NPASS - 1) / NPASS;
#pragma unroll 1
        for (int p = 0; p < NPASS; ++p) {
            const int t0 = p * TP, t1 = (t0 + TP < Gt) ? t0 + TP : Gt, ntile = t1 - t0;
            for (int rep = 0; rep < REPS(10); ++rep) { if (rep) GRID_BAR();
            if (IN(10 + 2 * p) && ntile > 0) {
                pg8::MoeOrder S{(const char*)HB, (const char*)Mgu, D, D, ntile, 2 * DFE / 256, G, bid, t0, (size_t)2 * DFE * D, tb, list, 1}; pg8::EpiSwiGLU<true> E{MACT, DFE, t0};
                pg8::gemm_phase<pg8::EpiSwiGLU<true>, pg8::MoeOrder, true, true, true, true>(lds, S, E, D, D, D);
            }
            }
            SEAM(10 + 2 * p);
            for (int rep = 0; rep < REPS(11); ++rep) { if (rep) GRID_BAR();
            if (IN(11 + 2 * p) && ntile > 0) {
                pg8::MoeOrder S{(const char*)MACT, (const char*)Md, DFE, DFE, ntile, D / 256, G, bid, t0, (size_t)D * DFE, tb, list, 0}; pg8::EpiMoeDown E{Yb, gsort, tb};
                pg8::gemm_phase<pg8::EpiMoeDown, pg8::MoeOrder, false, true, true, true>(lds, S, E, DFE, DFE, DFE);
            }
            }
            SEAM(11 + 2 * p);
        }
    }
    if (IN(NPHASE - 1)) combine_phase(tb, out, Yb, tokinfo, args.in[17], gw, ngw, lane);
#undef IN
#undef SEAM
}

extern "C" void kernel_launch(void* const* d_in, const int* in_sizes, int n_in, void* d_out, int out_size, void* d_ws, size_t ws_size, hipStream_t stream) {
    static int grid = 0;
    if (grid == 0) {
        if (n_in != 18 || in_sizes[0] != T * D || out_size != T * D || ws_size < WS_END) { fprintf(stderr, "kernel_launch: unexpected shapes / workspace (%d inputs, ws %zu < %zu)\n", n_in, ws_size, (size_t)WS_END); grid = -1; return; }
        int dev = 0, cus = 0, per_cu = 0;
        if (hipGetDevice(&dev) != hipSuccess || hipDeviceGetAttribute(&cus, hipDeviceAttributeMultiprocessorCount, dev) != hipSuccess) { grid = -1; return; }
        if (hipFuncSetAttribute((const void*)trunk_fwd, hipFuncAttributeMaxDynamicSharedMemorySize, LDS_BYTES) != hipSuccess) { fprintf(stderr, "kernel_launch: hipFuncSetAttribute failed\n"); grid = -1; return; }
        if (hipOccupancyMaxActiveBlocksPerMultiprocessor(&per_cu, (const void*)trunk_fwd, 512, LDS_BYTES) != hipSuccess || per_cu < 1) fprintf(stderr, "kernel_launch: occupancy query reports %d\n", per_cu);
        (void)hipGetLastError();
        grid = cus;
    }
    if (grid < 0) return;
    if (hipMemsetAsync((char*)d_ws + WS_CTL, 0, CTL_ZERO_BYTES, stream) != hipSuccess) return;
    Args a{};
    for (int i = 0; i < 18; ++i) a.in[i] = (const float*)d_in[i];
    a.out = (float*)d_out; a.ws = (unsigned char*)d_ws;
#if MK_PER_PHASE
    for (int ph = 0; ph < NPHASE; ++ph) { a.ph_lo = ph; a.ph_hi = ph + 1; hipLaunchKernelGGL(trunk_fwd, dim3(grid), dim3(512), LDS_BYTES, stream, a); }
#else
    a.ph_lo = 0; a.ph_hi = NPHASE;
    hipLaunchKernelGGL(trunk_fwd, dim3(grid), dim3(512), LDS_BYTES, stream, a);
#endif
}
```

```cpp
#include <hip/hip_runtime.h>
#include <cstdio>
#include <cstdint>

#ifndef MK_PER_PHASE
#define MK_PER_PHASE 0
#endif

#ifndef PROBE_REPEAT
#define PROBE_REPEAT -1
#endif
#ifndef PROBE_N
#define PROBE_N 2
#endif
#define REPS(k) ((PROBE_REPEAT) == (k) ? (PROBE_N) : 1)
#define LAS __attribute__((address_space(3)))
#define GAS __attribute__((address_space(1)))
typedef unsigned short bf16_t;
typedef short bf16x8 __attribute__((ext_vector_type(8)));
typedef short s16x4 __attribute__((ext_vector_type(4)));
typedef float f32x4 __attribute__((ext_vector_type(4)));
typedef float f32x2 __attribute__((ext_vector_type(2)));
typedef float f32x16 __attribute__((ext_vector_type(16)));
typedef unsigned u32x4 __attribute__((ext_vector_type(4)));
typedef unsigned u32x2 __attribute__((ext_vector_type(2)));
typedef __bf16 bf16v2 __attribute__((ext_vector_type(2)));
typedef int i32x8 __attribute__((ext_vector_type(8)));
typedef int i32x4 __attribute__((ext_vector_type(4)));

constexpr int BATCH = 8, SEQ = 4096, T = BATCH * SEQ, D = 1024, QKVW = 1536, DFF = 2816, NE = 8, DFE = 3584, NHEAD = 16, NKV = 4, HD = 64;
constexpr float RMS_EPS = 1e-5f, LOG2E = 1.4426950408889634f;
constexpr float QSCALE = 0.125f * LOG2E;
constexpr int NPASS = 1, TPMAX = 264, GMAX = 264;

constexpr size_t MiB = 1u << 20;
constexpr size_t WS_CTL = 0, CTL_ZERO_BYTES = 1 * MiB;
constexpr size_t WS_LIST = 1 * MiB;
constexpr size_t WS_GSORT = 2 * MiB;
constexpr size_t WS_TOKINFO = 3 * MiB;
constexpr size_t WS_WQKV = 4 * MiB;
constexpr size_t WS_WO = 7 * MiB;
constexpr size_t WS_WGU = 9 * MiB;
constexpr size_t WS_WD = 20 * MiB;
constexpr size_t WS_WP = 26 * MiB;
constexpr size_t WS_MGU = 27 * MiB;
constexpr size_t WS_MD = 83 * MiB;
constexpr size_t WS_HB = 111 * MiB;
constexpr size_t WS_B = 175 * MiB;
constexpr size_t WS_Y = WS_HB + 32 * MiB, WS_MACT = WS_Y + 132 * MiB;
constexpr size_t WS_END = WS_MACT + (size_t)TPMAX * 256 * DFE;
static_assert(WS_END <= 512 * MiB, "workspace");
static_assert((size_t)GMAX * 256 * D * 2 <= 132 * MiB, "y");
static_assert(WS_MGU + (size_t)NE * 2 * DFE * D <= WS_MD && WS_MD + (size_t)NE * D * DFE <= WS_HB && WS_HB + (size_t)T * D * 2 <= WS_B, "map");
static_assert(WS_B + (size_t)T * DFF * 2 <= 512 * MiB, "act");
constexpr int CW_TMO = 0;
constexpr int CW_BAR = 4096;
constexpr int CW_CNT = 16384;

constexpr int RING_BYTES = 131072;
constexpr int LDS_BYTES = 147456;
constexpr int MISC_OFF = 146432;

#define RLX_AGENT __ATOMIC_RELAXED, __HIP_MEMORY_SCOPE_AGENT
#define LDS_WAIT() asm volatile("s_waitcnt lgkmcnt(0)" ::: "memory")
#define VM_WAIT() asm volatile("s_waitcnt vmcnt(0)" ::: "memory")

__device__ __forceinline__ unsigned pk2(float lo, float hi) { bf16v2 v = {(__bf16)lo, (__bf16)hi}; return __builtin_bit_cast(unsigned, v); }
constexpr float W8_SCALE = 64.0f, W8_INV = 1.0f / 64.0f;
__device__ __forceinline__ float clamp8(float x) { return __builtin_fminf(__builtin_fmaxf(x, -448.0f), 448.0f); }
__device__ __forceinline__ unsigned pk4_fp8(float a, float b, float c, float d) {
    unsigned w = 0u; w = (unsigned)__builtin_amdgcn_cvt_pk_fp8_f32(clamp8(a), clamp8(b), (int)w, false); w = (unsigned)__builtin_amdgcn_cvt_pk_fp8_f32(clamp8(c), clamp8(d), (int)w, true); return w; }
__device__ __forceinline__ int opaque_tid() { int t = threadIdx.x; asm volatile("" : "+v"(t)); return t; }
__device__ __forceinline__ float wave_sum(float v) {
#pragma unroll
    for (int o = 1; o < 64; o <<= 1) v += __shfl_xor(v, o);
    return v;
}

#define XB_TMO      128
#define XB_XCNT(j)  (256  + 64 * (j))
#define XB_XSUB(j)  (1280 + 64 * (j))
#define XB_XGEN(j)  (2304 + 64 * (j))
#define XB_TOP      3328
#define XB_TOPGEN   3392
#define XCD_BAR_WORDS 3456
#define XB_SPIN_CAP (1u << 18)
__device__ __forceinline__ unsigned xb_ld(unsigned* p)              { return __hip_atomic_load(p, __ATOMIC_RELAXED, __HIP_MEMORY_SCOPE_AGENT); }
__device__ __forceinline__ unsigned xb_add(unsigned* p, unsigned v) { return __hip_atomic_fetch_add(p, v, __ATOMIC_RELAXED, __HIP_MEMORY_SCOPE_AGENT); }
__device__ __forceinline__ unsigned xb_xcc_id() { return (unsigned)__builtin_amdgcn_s_getreg((3 << 11) | 20) & 0xFu; }
#define XB_SPIN(cond, bar) do { unsigned _sp = 0; while (cond) { __builtin_amdgcn_s_sleep(1); \
    if ((++_sp & 255u) == 0u) { if (xb_ld(&(bar)[XB_TMO])) break; if (_sp > XB_SPIN_CAP) { atomicAdd(&(bar)[XB_TMO], 1u); break; } } } } while (0)
struct XcdBarrier { unsigned* bar; unsigned x; volatile LAS unsigned* st; };
__device__ __forceinline__ XcdBarrier xcd_barrier_post(unsigned* bar, volatile LAS unsigned* st) {
    XcdBarrier b; b.bar = bar; b.x = xb_xcc_id(); b.st = st;
    if (threadIdx.x == 0) (void)xb_add(&bar[XB_XCNT(b.x)], 1u);
    return b;
}
__device__ __forceinline__ void xcd_barrier_complete(unsigned* bar, unsigned x, unsigned& nloc, unsigned& nx) {
    const unsigned G = gridDim.x * gridDim.y * gridDim.z;
    unsigned sum, cnt, mine, sp = 0u;
    for (;;) {
        sum = 0u; cnt = 0u; mine = 0u;
#pragma unroll
        for (unsigned j = 0; j < 16; ++j) { const unsigned c = xb_ld(&bar[XB_XCNT(j)]); sum += c; cnt += (c > 0u) ? 1u : 0u; mine = (j == x) ? c : mine; }
        if (sum == G) break;
        __builtin_amdgcn_s_sleep(1);
        if ((++sp & 255u) == 0u) { if (xb_ld(&bar[XB_TMO])) break; if (sp > XB_SPIN_CAP) { atomicAdd(&bar[XB_TMO], 1u); break; } }
    }
    nloc = mine > 0u ? mine : 1u; nx = cnt > 0u ? cnt : 1u;
}
__device__ __forceinline__ void xcd_barrier(const XcdBarrier& b) {
    asm volatile("s_waitcnt vmcnt(0)" ::: "memory");
    __syncthreads();
    if (threadIdx.x == 0) {
        unsigned* bar = b.bar;
        __builtin_amdgcn_s_waitcnt(0);
        unsigned nloc = b.st[0], nx = b.st[1];
        if (nloc == 0u) { xcd_barrier_complete(bar, b.x, nloc, nx); b.st[0] = nloc; b.st[1] = nx; }
        const unsigned old = xb_add(&bar[XB_XSUB(b.x)], 1u);
        const unsigned gen = old / nloc;
        if (old + 1u == (gen + 1u) * nloc) {
            __builtin_amdgcn_fence(__ATOMIC_RELEASE, "agent");
            asm volatile("s_waitcnt vmcnt(0)" ::: "memory");
            const unsigned og = xb_add(&bar[XB_TOP], 1u);
            const unsigned tg = og / nx;
            if (og + 1u == (tg + 1u) * nx) xb_add(&bar[XB_TOPGEN], 1u);
            else XB_SPIN(xb_ld(&bar[XB_TOPGEN]) == tg, bar);
            __builtin_amdgcn_fence(__ATOMIC_ACQUIRE, "agent");
            xb_add(&bar[XB_XGEN(b.x)], 1u);
            asm volatile("s_waitcnt vmcnt(0)" ::: "memory");
        } else {
            XB_SPIN(xb_ld(&bar[XB_XGEN(b.x)]) == gen, bar);
            __builtin_amdgcn_fence(__ATOMIC_ACQUIRE, "agent");
            asm volatile("s_waitcnt vmcnt(0)" ::: "memory");
        }
    }
    __syncthreads();
}

namespace pg8 {
constexpr int BM = 256, BK = 64, HALF = 128, HTB = HALF * BK * 2, NXCD = 8, WGM = 8;
__device__ __forceinline__ int lds_byte(int r, int c) { const int st = (r >> 4) * 2 + (c >> 5), rr = r & 15, cc = c & 31, ob = rr * 64 + cc * 2; return st * 1024 + (ob ^ (((ob >> 9) & 1) << 5)); }
__device__ __forceinline__ void stage_rc(int b, int& R, int& C) { const int st = b / 1024, sb = b % 1024, swz = sb ^ (((sb >> 9) & 1) << 5); R = (st >> 1) * 16 + swz / 64; C = (st & 1) * 32 + (swz % 64) / 2; }
__device__ __forceinline__ int perm32(int rho) { const int n = rho >> 4, i = rho & 15; return 8 * (i >> 2) + 4 * n + (i & 3); }

struct Unit { int pm, pn, e; };

__device__ __forceinline__ bool tile_of(int i, int G, int c, int nM, int nN, int& pm, int& pn) {
    const int nwg = nM * nN; const int L = i * G + c; if (L >= nwg) return false;
    int wgid = L; { const int q = nwg / NXCD, r = nwg % NXCD, xcd = wgid % NXCD, off = wgid / NXCD; wgid = (xcd < r ? xcd * (q + 1) : r * (q + 1) + (xcd - r) * q) + off; }
    const int nig = WGM * nN, gid = wgid / nig, fm = gid * WGM, gsz = (nM - fm) < WGM ? (nM - fm) : WGM;
    pm = fm + ((wgid % nig) % gsz); pn = (wgid % nig) / gsz; return true;
}
struct DenseOrder {
    const char* A; const char* Bt; int lda, ldb, nM, nN, G, c; int grouped;
    __device__ __forceinline__ bool next(int i, Unit& u) const { u.e = 0; return tile_of(i, G, c, nM, nN, u.pm, u.pn); }
    __device__ __forceinline__ const char* a_base(const Unit& u) const { return A + (size_t)u.pm * 256 * lda + (grouped ? u.pn * 512 : 0); }
    __device__ __forceinline__ const char* b_base(const Unit& u) const { return Bt + (size_t)u.pn * 256 * ldb; }
    __device__ __forceinline__ int grow(const Unit&, int) const { return 0; }
};
struct MoeOrder {
    const char* A; const char* Bt; int lda, ldb, nM, nN, G, c, t0; size_t bstride;
    const volatile LAS int* tb; const int* list; int gather;
    __device__ __forceinline__ bool next(int i, Unit& u) const {
        if (!tile_of(i, G, c, nM, nN, u.pm, u.pn)) return false;
        u.pm += t0; int e = 0;
#pragma unroll
        for (int j = 1; j < 8; ++j) e += (u.pm >= tb[j]) ? 1 : 0;
        u.e = __builtin_amdgcn_readfirstlane(e); return true;
    }
    __device__ __forceinline__ const char* a_base(const Unit& u) const { return gather ? A : A + (size_t)(u.pm - t0) * 256 * lda; }
    __device__ __forceinline__ const char* b_base(const Unit& u) const { return Bt + (size_t)u.e * bstride + (size_t)u.pn * 256 * ldb; }
    __device__ __forceinline__ int grow(const Unit& u, int r) const {
        const int tbe = __builtin_amdgcn_readfirstlane(tb[u.e]), n = __builtin_amdgcn_readfirstlane(tb[16 + u.e]);
        int p = (u.pm - tbe) * 256 + r; p = p < n ? p : n - 1;
        return list[u.e * T + p];
    }
};

struct EpiQKV {
    static constexpr bool PERM = true; static constexpr int PROBE_ID = 1;
    bf16_t* O;
    __device__ __forceinline__ void operator()(const f32x4 (&acc)[2][2][4][2], const Unit& u, int wr, int wc, int fr, int fq) const {
        const int row0 = u.pm * BM + wr * 64 + fr, col0 = u.pn * BM + wc * 32 + 8 * fq; const float sc = (u.pn < 4) ? QSCALE : 1.0f;
#pragma unroll
        for (int ai = 0; ai < 2; ++ai)
#pragma unroll
            for (int m = 0; m < 4; ++m) { bf16_t* rowp = O + (size_t)(row0 + ai * HALF + m * 16) * QKVW + col0;
#pragma unroll
                for (int bj = 0; bj < 2; ++bj) { const f32x4 v0 = acc[ai][bj][m][0] * sc, v1 = acc[ai][bj][m][1] * sc;
                    u32x4 w; w.x = pk2(v0[0], v0[1]); w.y = pk2(v0[2], v0[3]); w.z = pk2(v1[0], v1[1]); w.w = pk2(v1[2], v1[3]);
                    *(u32x4*)(rowp + bj * HALF) = w; } }
    }
};
struct EpiResF32 {
    static constexpr bool PERM = true; static constexpr int PROBE_ID = 3;
    const float* res; float* out; const float* scale;
    __device__ __forceinline__ void operator()(const f32x4 (&acc)[2][2][4][2], const Unit& u, int wr, int wc, int fr, int fq) const {
        const int row0 = u.pm * BM + wr * 64 + fr, col0 = u.pn * BM + wc * 32 + 8 * fq;
#pragma unroll
        for (int bj = 0; bj < 2; ++bj) {
            f32x4 s0 = (f32x4){1.f, 1.f, 1.f, 1.f}, s1 = s0;
            if (scale) { s0 = *(const f32x4*)(scale + col0 + bj * HALF); s1 = *(const f32x4*)(scale + col0 + bj * HALF + 4); }
#pragma unroll
            for (int ai = 0; ai < 2; ++ai) {
#pragma unroll
                for (int m = 0; m < 4; ++m) { const size_t off = (size_t)(row0 + ai * HALF + m * 16) * D + col0 + bj * HALF;
                    const f32x4 r0 = *(const f32x4*)(res + off), r1 = *(const f32x4*)(res + off + 4);
                    *(f32x4*)(out + off) = r0 + acc[ai][bj][m][0] * s0; *(f32x4*)(out + off + 4) = r1 + acc[ai][bj][m][1] * s1; }
                asm volatile("" ::: "memory"); } }
    }
};
__device__ __forceinline__ float silu_mul(float g, float u) { return g * u * __builtin_amdgcn_rcpf(1.0f + __builtin_amdgcn_exp2f(-g * LOG2E)); }
template <bool F8> struct EpiSwiGLU {
    static constexpr bool PERM = true; static constexpr int PROBE_ID = 5;
    unsigned char* O; int ldc, tile0;
    __device__ __forceinline__ void operator()(const f32x4 (&acc)[2][2][4][2], const Unit& u, int wr, int wc, int fr, int fq) const {
        const int row0 = (u.pm - tile0) * BM + wr * 64 + fr, col0 = u.pn * HALF + wc * 32 + 8 * fq;
#pragma unroll
        for (int ai = 0; ai < 2; ++ai)
#pragma unroll
            for (int m = 0; m < 4; ++m) { unsigned char* rowp = O + (size_t)(row0 + ai * HALF + m * 16) * ldc + col0 * (F8 ? 1 : 2);
                f32x4 g0 = acc[ai][0][m][0], g1 = acc[ai][0][m][1], u0 = acc[ai][1][m][0], u1 = acc[ai][1][m][1];
                if constexpr (F8) { g0 *= W8_INV; g1 *= W8_INV; u0 *= W8_INV; u1 *= W8_INV;
                    u32x2 w; w.x = pk4_fp8(silu_mul(g0[0], u0[0]), silu_mul(g0[1], u0[1]), silu_mul(g0[2], u0[2]), silu_mul(g0[3], u0[3]));
                    w.y = pk4_fp8(silu_mul(g1[0], u1[0]), silu_mul(g1[1], u1[1]), silu_mul(g1[2], u1[2]), silu_mul(g1[3], u1[3]));
                    *(u32x2*)rowp = w; }
                else { u32x4 w; w.x = pk2(silu_mul(g0[0], u0[0]), silu_mul(g0[1], u0[1])); w.y = pk2(silu_mul(g0[2], u0[2]), silu_mul(g0[3], u0[3]));
                    w.z = pk2(silu_mul(g1[0], u1[0]), silu_mul(g1[1], u1[1])); w.w = pk2(silu_mul(g1[2], u1[2]), silu_mul(g1[3], u1[3]));
                    *(u32x4*)rowp = w; } }
    }
};
struct EpiMoeDown {
    static constexpr bool PERM = true; static constexpr int PROBE_ID = 11;
    bf16_t* Y; const float* gsort; const volatile LAS int* tb;
    __device__ __forceinline__ void operator()(const f32x4 (&acc)[2][2][4][2], const Unit& u, int wr, int wc, int fr, int fq) const {
        const int lrow0 = wr * 64 + fr, col0 = u.pn * BM + wc * 32 + 8 * fq; const int p0 = (u.pm - __builtin_amdgcn_readfirstlane(tb[u.e])) * 256, n = __builtin_amdgcn_readfirstlane(tb[16 + u.e]);
#pragma unroll
        for (int ai = 0; ai < 2; ++ai)
#pragma unroll
            for (int m = 0; m < 4; ++m) { const int lr = lrow0 + ai * HALF + m * 16; const int pp = p0 + lr; const float gw = gsort[u.e * T + (pp < n ? pp : n - 1)] * W8_INV;
                bf16_t* rowp = Y + (size_t)(u.pm * 256 + lr) * D + col0;
#pragma unroll
                for (int bj = 0; bj < 2; ++bj) { const f32x4 v0 = acc[ai][bj][m][0] * gw, v1 = acc[ai][bj][m][1] * gw;
                    u32x4 w; w.x = pk2(v0[0], v0[1]); w.y = pk2(v0[2], v0[3]); w.z = pk2(v1[0], v1[1]); w.w = pk2(v1[2], v1[3]);
                    *(u32x4*)(rowp + bj * HALF) = w; } }
    }
};

template <class Epi, class Sched, bool GATHER, bool ALIGN_EPI, bool SP2, bool FP8>
__device__ __forceinline__ void gemm_phase(LAS unsigned char* lds, const Sched& S, const Epi& E, const int Kb, const int lda, const int ldb) {
    int tid_ = threadIdx.x; asm volatile("" : "+v"(tid_));
    const int tid = tid_, wid = __builtin_amdgcn_readfirstlane(tid >> 6), lane = tid & 63, wr = wid >> 2, wc = wid & 3, fr = lane & 15, fq = lane >> 4;
    int nt_ = Kb / 128; asm volatile("" : "+s"(nt_)); const int nt = nt_;
    unsigned voffA[2][2], voffB[2];
#pragma unroll
    for (int i = 0; i < 2; ++i) { int R, C; stage_rc(tid * 16 + i * 8192, R, C); const int Rb = Epi::PERM ? ((R & ~31) + perm32(R & 31)) : R;
        voffA[0][i] = (unsigned)(R * lda + 2 * C); voffA[1][i] = 0u; voffB[i] = (unsigned)(Rb * ldb + 2 * C); }
    constexpr int kstep = BK * 2;
    const int hstepB = HALF * ldb;
    const int hstepA = GATHER ? 0 : HALF * lda;
    const unsigned ldsw = (unsigned)wid * 1024u;
    const int aoff = lds_byte(wr * 64 + fr, fq * 8), boff = lds_byte(wc * 32 + fr, fq * 8);
#define PG8_SA(b, h) (((b) * 2 + (h)) * HTB)
#define PG8_SB(b, h) ((4 + (b) * 2 + (h)) * HTB)
#define PG8_STAGE(bufoff, gbase, voff) do { _Pragma("unroll") for (int _i = 0; _i < 2; ++_i) \
        __builtin_amdgcn_global_load_lds((const unsigned*)((const char*)(gbase) + (voff)[_i]), (LAS unsigned*)(lds + (bufoff) + ldsw + _i * 8192), 16, 0, 0); } while (0)
#define PG8_LDA(dst, b, h) do { _Pragma("unroll") for (int m = 0; m < 4; ++m) { const LAS i32x4* _p = (const LAS i32x4*)(lds + PG8_SA(b, h) + aoff + m * 2048); const i32x4 _lo = _p[0], _hi = _p[64]; \
        dst[m] = __builtin_shufflevector(_lo, _hi, 0, 1, 2, 3, 4, 5, 6, 7); } } while (0)
#define PG8_LDB(dst, b, h) do { _Pragma("unroll") for (int n = 0; n < 2; ++n) { const LAS i32x4* _p = (const LAS i32x4*)(lds + PG8_SB(b, h) + boff + n * 2048); const i32x4 _lo = _p[0], _hi = _p[64]; \
        dst[n] = __builtin_shufflevector(_lo, _hi, 0, 1, 2, 3, 4, 5, 6, 7); } } while (0)
#define PG8_MMA(ai, bj, At, Bt) do { __builtin_amdgcn_s_setprio(1); _Pragma("unroll") for (int m = 0; m < 4; ++m) _Pragma("unroll") for (int n = 0; n < 2; ++n) { \
        if constexpr (FP8) { asm volatile("v_mfma_scale_f32_16x16x128_f8f6f4 %0, %1, %2, %0, %3, %3 op_sel_hi:[0,0,0]" : "+v"(acc[ai][bj][m][n]) : "v"(Bt[n]), "v"(At[m]), "v"(one8)); } \
        else { acc[ai][bj][m][n] = __builtin_amdgcn_mfma_f32_16x16x32_bf16(__builtin_bit_cast(bf16x8, __builtin_shufflevector(Bt[n], Bt[n], 0, 1, 2, 3)), __builtin_bit_cast(bf16x8, __builtin_shufflevector(At[m], At[m], 0, 1, 2, 3)), acc[ai][bj][m][n], 0, 0, 0); \
               acc[ai][bj][m][n] = __builtin_amdgcn_mfma_f32_16x16x32_bf16(__builtin_bit_cast(bf16x8, __builtin_shufflevector(Bt[n], Bt[n], 4, 5, 6, 7)), __builtin_bit_cast(bf16x8, __builtin_shufflevector(At[m], At[m], 4, 5, 6, 7)), acc[ai][bj][m][n], 0, 0, 0); } } \
        __builtin_amdgcn_s_setprio(0); } while (0)
#define PG8_WAIT_V(n) asm volatile("s_waitcnt vmcnt(" #n ")" ::: "memory")
#define PG8_WAIT_L(n) asm volatile("s_waitcnt lgkmcnt(" #n ")" ::: "memory")
#define PG8_BAR __builtin_amdgcn_s_barrier()
#define PG8_SCHED __builtin_amdgcn_sched_barrier(0)
#define PG8_GOFF(dst, unit) do { _Pragma("unroll") for (int _i = 0; _i < 2; ++_i) { int _R, _C; stage_rc(tid * 16 + _i * 8192, _R, _C); \
        dst[0][_i] = (unsigned)(S.grow(unit, _R) * lda + 2 * _C); dst[1][_i] = (unsigned)(S.grow(unit, _R + HALF) * lda + 2 * _C); } } while (0)
    Unit cur, nxt; int ui = 0;
    if (!S.next(0, cur)) return;
    f32x4 acc[2][2][4][2];
#pragma unroll
    for (int a = 0; a < 2; ++a)
#pragma unroll
        for (int b = 0; b < 2; ++b)
#pragma unroll
            for (int m = 0; m < 4; ++m)
#pragma unroll
                for (int n = 0; n < 2; ++n) acc[a][b][m][n] = (f32x4){0.f, 0.f, 0.f, 0.f};
    int one8 = 0x7F7F7F7F; asm volatile("" : "+v"(one8));
    i32x8 At[4], B0[2], B1[2];
    const char* cA = S.a_base(cur); const char* cB = S.b_base(cur);
    if constexpr (GATHER) { PG8_GOFF(voffA, cur); }
    if constexpr (SP2) {
        PG8_STAGE(PG8_SB(0, 0), cB, voffB); PG8_STAGE(PG8_SB(0, 1), cB + hstepB, voffB); PG8_STAGE(PG8_SA(0, 0), cA, voffA[0]); PG8_STAGE(PG8_SA(0, 1), cA + hstepA, voffA[GATHER ? 1 : 0]);
        if (wr == 1) PG8_BAR;
        PG8_WAIT_V(2); PG8_BAR;
        PG8_STAGE(PG8_SB(1, 0), cB + kstep, voffB); PG8_STAGE(PG8_SA(1, 0), cA + kstep, voffA[0]); PG8_STAGE(PG8_SB(1, 1), cB + hstepB + kstep, voffB);
        PG8_WAIT_V(6); PG8_BAR;
    } else {
        PG8_STAGE(PG8_SB(0, 0), cB, voffB); PG8_STAGE(PG8_SA(0, 0), cA, voffA[0]); PG8_STAGE(PG8_SB(0, 1), cB + hstepB, voffB); PG8_STAGE(PG8_SA(0, 1), cA + hstepA, voffA[GATHER ? 1 : 0]);
        if (wr == 1) PG8_BAR;
        PG8_WAIT_V(4); PG8_BAR;
        PG8_STAGE(PG8_SB(1, 0), cB + kstep, voffB); PG8_STAGE(PG8_SA(1, 0), cA + kstep, voffA[0]); PG8_STAGE(PG8_SB(1, 1), cB + hstepB + kstep, voffB);
        PG8_WAIT_V(6); PG8_BAR;
    }
    for (;;) {
        const bool has_next = S.next(ui + 1, nxt);
        const char* nA = has_next ? S.a_base(nxt) : cA; const char* nB = has_next ? S.b_base(nxt) : cB;
        for (int t = 0; t < nt; t += 2) {
            const bool last = (t == nt - 2);
            const char* a1 = cA + (t + 1) * kstep;
            const char* a2 = last ? nA : cA + (t + 2) * kstep; const char* b2 = last ? nB : cB + (t + 2) * kstep;
            const char* a3 = a2 + kstep; const char* b3 = b2 + kstep;
            unsigned nv[2][2];
            if constexpr (GATHER) { if (last && has_next) { PG8_GOFF(nv, nxt); } }
            if constexpr (SP2) {
            PG8_LDB(B0, 0, 0); PG8_LDB(B1, 0, 1); PG8_SCHED; PG8_LDA(At, 0, 0); PG8_STAGE(PG8_SA(1, 1), a1 + hstepA, voffA[GATHER ? 1 : 0]);
            if constexpr (GATHER) { if (last && has_next) { voffA[0][0] = nv[0][0]; voffA[0][1] = nv[0][1]; voffA[1][0] = nv[1][0]; voffA[1][1] = nv[1][1]; } }
            PG8_WAIT_V(8); PG8_WAIT_L(0); PG8_BAR; PG8_MMA(0, 0, At, B0); PG8_MMA(0, 1, At, B1); PG8_BAR; PG8_SCHED;
            PG8_LDA(At, 0, 1); PG8_STAGE(PG8_SB(0, 0), b2, voffB); PG8_STAGE(PG8_SB(0, 1), b2 + hstepB, voffB); PG8_STAGE(PG8_SA(0, 0), a2, voffA[0]);
            PG8_WAIT_V(8); PG8_WAIT_L(0); PG8_BAR; PG8_MMA(1, 0, At, B0); PG8_MMA(1, 1, At, B1); PG8_BAR; PG8_SCHED;
            PG8_LDB(B0, 1, 0); PG8_LDB(B1, 1, 1); PG8_SCHED; PG8_LDA(At, 1, 0); PG8_STAGE(PG8_SA(0, 1), a2 + hstepA, voffA[GATHER ? 1 : 0]);
            PG8_WAIT_V(8); PG8_WAIT_L(0); PG8_BAR; PG8_MMA(0, 0, At, B0); PG8_MMA(0, 1, At, B1); PG8_BAR; PG8_SCHED;
            PG8_LDA(At, 1, 1); PG8_STAGE(PG8_SB(1, 0), b3, voffB); PG8_STAGE(PG8_SB(1, 1), b3 + hstepB, voffB); PG8_STAGE(PG8_SA(1, 0), a3, voffA[0]);
            PG8_WAIT_V(8); PG8_WAIT_L(0); PG8_BAR; PG8_MMA(1, 0, At, B0); PG8_MMA(1, 1, At, B1); PG8_BAR; PG8_SCHED;
            } else {
            PG8_LDB(B0, 0, 0); PG8_SCHED; PG8_LDA(At, 0, 0); PG8_STAGE(PG8_SA(1, 1), a1 + hstepA, voffA[GATHER ? 1 : 0]);
            if constexpr (GATHER) { if (last && has_next) { voffA[0][0] = nv[0][0]; voffA[0][1] = nv[0][1]; voffA[1][0] = nv[1][0]; voffA[1][1] = nv[1][1]; } }
            PG8_WAIT_L(8); PG8_BAR; PG8_WAIT_L(0); PG8_MMA(0, 0, At, B0); PG8_BAR; PG8_SCHED;
            PG8_LDB(B1, 0, 1); PG8_STAGE(PG8_SB(0, 0), b2, voffB);
            PG8_BAR; PG8_WAIT_L(0); PG8_MMA(0, 1, At, B1); PG8_BAR;
            PG8_LDA(At, 0, 1); PG8_STAGE(PG8_SA(0, 0), a2, voffA[0]);
            PG8_BAR; PG8_WAIT_L(0); PG8_MMA(1, 0, At, B0); PG8_BAR; PG8_SCHED;
            PG8_STAGE(PG8_SB(0, 1), b2 + hstepB, voffB);
            PG8_WAIT_V(6); PG8_BAR; PG8_MMA(1, 1, At, B1); PG8_BAR;
            PG8_LDB(B0, 1, 0); PG8_SCHED; PG8_LDA(At, 1, 0); PG8_STAGE(PG8_SA(0, 1), a2 + hstepA, voffA[GATHER ? 1 : 0]);
            PG8_WAIT_L(8); PG8_BAR; PG8_WAIT_L(0); PG8_MMA(0, 0, At, B0); PG8_BAR; PG8_SCHED;
            PG8_LDB(B1, 1, 1); PG8_STAGE(PG8_SB(1, 0), b3, voffB);
            PG8_BAR; PG8_WAIT_L(0); PG8_MMA(0, 1, At, B1); PG8_BAR;
            PG8_LDA(At, 1, 1); PG8_STAGE(PG8_SA(1, 0), a3, voffA[0]);
            PG8_BAR; PG8_WAIT_L(0); PG8_MMA(1, 0, At, B0); PG8_BAR; PG8_SCHED;
            PG8_STAGE(PG8_SB(1, 1), b3 + hstepB, voffB);
            PG8_WAIT_V(6); PG8_BAR; PG8_MMA(1, 1, At, B1); PG8_BAR;
            }
        }
        if constexpr (FP8) {
            asm volatile("s_nop 15\n\ts_nop 7" ::: "memory");
#pragma unroll
            for (int a = 0; a < 2; ++a)
#pragma unroll
                for (int b = 0; b < 2; ++b) asm volatile("" : "+v"(acc[a][b][0][0]), "+v"(acc[a][b][0][1]), "+v"(acc[a][b][1][0]), "+v"(acc[a][b][1][1]), "+v"(acc[a][b][2][0]), "+v"(acc[a][b][2][1]), "+v"(acc[a][b][3][0]), "+v"(acc[a][b][3][1]));
        }
        if constexpr (ALIGN_EPI) { if (wr == 0) PG8_BAR; }
        E(acc, cur, wr, wc, fr, fq);
#if PROBE_REPEAT == 105
        if constexpr (Epi::PROBE_ID == 5) { asm volatile("s_waitcnt vmcnt(0)" ::: "memory"); E(acc, cur, wr, wc, fr, fq); }
#endif
        if (!has_next) break;
#pragma unroll
        for (int a = 0; a < 2; ++a)
#pragma unroll
            for (int b = 0; b < 2; ++b)
#pragma unroll
                for (int m = 0; m < 4; ++m)
#pragma unroll
                    for (int n = 0; n < 2; ++n) acc[a][b][m][n] = (f32x4){0.f, 0.f, 0.f, 0.f};
        cur = nxt; cA = nA; cB = nB; ++ui;
        if constexpr (FP8) asm volatile("s_nop 3" ::: "memory");
        if constexpr (ALIGN_EPI) { if (wr == 1) PG8_BAR; }
    }
    PG8_WAIT_V(0);
    if constexpr (!ALIGN_EPI) { if (wr == 0) PG8_BAR; }
    PG8_BAR;
#undef PG8_SA
#undef PG8_SB
#undef PG8_STAGE
#undef PG8_LDA
#undef PG8_LDB
#undef PG8_MMA
#undef PG8_WAIT_V
#undef PG8_WAIT_L
#undef PG8_BAR
#undef PG8_SCHED
#undef PG8_GOFF
}
}

struct TItem { const float* src; void* dst; int N, K, k0, n0, drow0, f8; };
__device__ __forceinline__ void titem_load(const TItem& t, f32x4 (&r)[16], int lane) {
    const float* p = t.src + (size_t)(t.k0 + (lane >> 4)) * t.N + t.n0 + 4 * (lane & 15);
#pragma unroll
    for (int i = 0; i < 16; ++i) r[i] = *(const f32x4*)(p + (size_t)(4 * i) * t.N);
}
__device__ __forceinline__ void titem_to_lds(const f32x4 (&r)[16], LAS float* scr, int lane) {
    LAS float* q = scr + (lane >> 4) * 65 + 4 * (lane & 15);
#pragma unroll
    for (int i = 0; i < 16; ++i) { q[(4 * i) * 65 + 0] = r[i].x; q[(4 * i) * 65 + 1] = r[i].y; q[(4 * i) * 65 + 2] = r[i].z; q[(4 * i) * 65 + 3] = r[i].w; }
}
__device__ __forceinline__ void titem_store(const TItem& t, const LAS float* scr, int lane) {
    if (t.f8) { const int c = lane & 3; unsigned char* WT = (unsigned char*)t.dst;
#pragma unroll
        for (int j = 0; j < 4; ++j) { const int n = (lane >> 2) + 16 * j; const LAS float* s = scr + (16 * c) * 65 + n;
            u32x4 o; o.x = pk4_fp8(s[0 * 65] * W8_SCALE, s[1 * 65] * W8_SCALE, s[2 * 65] * W8_SCALE, s[3 * 65] * W8_SCALE); o.y = pk4_fp8(s[4 * 65] * W8_SCALE, s[5 * 65] * W8_SCALE, s[6 * 65] * W8_SCALE, s[7 * 65] * W8_SCALE);
            o.z = pk4_fp8(s[8 * 65] * W8_SCALE, s[9 * 65] * W8_SCALE, s[10 * 65] * W8_SCALE, s[11 * 65] * W8_SCALE); o.w = pk4_fp8(s[12 * 65] * W8_SCALE, s[13 * 65] * W8_SCALE, s[14 * 65] * W8_SCALE, s[15 * 65] * W8_SCALE);
            *(u32x4*)(WT + (size_t)(t.drow0 + n) * t.K + t.k0 + 16 * c) = o; }
    } else { const int c = lane & 7; bf16_t* WT = (bf16_t*)t.dst;
#pragma unroll
        for (int j = 0; j < 8; ++j) { const int n = (lane >> 3) + 8 * j; const LAS float* s = scr + (8 * c) * 65 + n;
            u32x4 o; o.x = pk2(s[0 * 65], s[1 * 65]); o.y = pk2(s[2 * 65], s[3 * 65]); o.z = pk2(s[4 * 65], s[5 * 65]); o.w = pk2(s[6 * 65], s[7 * 65]);
            *(u32x4*)(WT + (size_t)(t.drow0 + n) * t.K + t.k0 + 8 * c) = o; }
    }
}
__device__ __forceinline__ void rms_rows2(const float* x0, const float* x1, bool two, const f32x4 (&gn)[4], bf16_t* o0, bf16_t* o1, int lane) {
    const f32x4* xa = (const f32x4*)x0 + lane; const f32x4* xb = (const f32x4*)x1 + lane;
    f32x4 va[4], vb[4]; float sa = 0.f, sb = 0.f;
#pragma unroll
    for (int j = 0; j < 4; ++j) { va[j] = xa[64 * j]; vb[j] = xb[64 * j]; }
#pragma unroll
    for (int j = 0; j < 4; ++j) { sa += (va[j].x * va[j].x + va[j].y * va[j].y) + (va[j].z * va[j].z + va[j].w * va[j].w); sb += (vb[j].x * vb[j].x + vb[j].y * vb[j].y) + (vb[j].z * vb[j].z + vb[j].w * vb[j].w); }
    const float ra = 1.0f / sqrtf(wave_sum(sa) * (1.f / D) + RMS_EPS), rb = 1.0f / sqrtf(wave_sum(sb) * (1.f / D) + RMS_EPS);
    u32x2* pa = (u32x2*)o0 + lane; u32x2* pb = (u32x2*)o1 + lane;
#pragma unroll
    for (int j = 0; j < 4; ++j) { const f32x4 y = va[j] * ra * gn[j]; u32x2 w; w.x = pk2(y.x, y.y); w.y = pk2(y.z, y.w); pa[64 * j] = w; }
    if (two) {
#pragma unroll
        for (int j = 0; j < 4; ++j) { const f32x4 y = vb[j] * rb * gn[j]; u32x2 w; w.x = pk2(y.x, y.y); w.y = pk2(y.z, y.w); pb[64 * j] = w; } }
}
__device__ __forceinline__ void rms_phase(const float* X, const float* gain, bf16_t* O, int G, int bid) {
    const int tid = opaque_tid(), lane = tid & 63, gw = bid * 8 + __builtin_amdgcn_readfirstlane(tid >> 6), ngw = G * 8;
    f32x4 gn[4];
#pragma unroll
    for (int j = 0; j < 4; ++j) gn[j] = ((const f32x4*)gain)[lane + 64 * j];
    for (int m = gw; m < T; m += 2 * ngw) { const int m1 = m + ngw; const bool two = m1 < T; const int mb = two ? m1 : m;
        rms_rows2(X + (size_t)m * D, X + (size_t)mb * D, two, gn, O + (size_t)m * D, O + (size_t)mb * D, lane); }
}

__device__ __forceinline__ unsigned ks_off(int key, int c) { return (unsigned)(key * 128 + ((c ^ ((key >> 1) & 7)) << 4)); }
__device__ __forceinline__ unsigned vs_off(int key, int c) { return (unsigned)(key * 128 + ((c ^ (((key >> 1) & 1) << 2)) << 4)); }
template <int OFF> __device__ __forceinline__ void tr_read4(s16x4& a, s16x4& b, s16x4& c, s16x4& d, unsigned b0, unsigned b1) {
    asm volatile("ds_read_b64_tr_b16 %0, %4 offset:%6\n\tds_read_b64_tr_b16 %1, %4 offset:%7\n\tds_read_b64_tr_b16 %2, %5 offset:%6\n\tds_read_b64_tr_b16 %3, %5 offset:%7\n\ts_waitcnt lgkmcnt(0)"
                 : "=&v"(a), "=&v"(b), "=&v"(c), "=&v"(d) : "v"(b0), "v"(b1), "i"(OFF), "i"(OFF + 1024) : "memory");
}
__device__ __forceinline__ void attn_phase(LAS unsigned char* lds, const bf16_t* QKV, bf16_t* O, const float* sinks, int G, int bid) {
    const int tid = opaque_tid(), lane = tid & 63, wid = __builtin_amdgcn_readfirstlane(tid >> 6);
    const int g = wid >> 1, half = wid & 1, ql = lane & 31, h = lane >> 5;
    LAS unsigned char* Ks = lds; LAS unsigned char* Vs = lds + 32768;
    const int i16 = lane & 15, tq = i16 >> 2, tp = i16 & 3, blk = (lane >> 4) & 1;
    for (int u = bid; u < BATCH * 32 * NKV; u += G) {
        const int kvh = u & 3, bn = u >> 2, n = bn & 31, b = bn >> 5;
        const int tok0 = b * SEQ + n * 128;
        __syncthreads();
#pragma unroll
        for (int i = 0; i < 4; ++i) { const int q = tid + 512 * i, row = q >> 3, c = q & 7; const bool valid = (n > 0) || (row >= 128);
            u32x4 kv = (u32x4){0u, 0u, 0u, 0u}, vv = (u32x4){0u, 0u, 0u, 0u};
            if (valid) { const bf16_t* p = QKV + (size_t)(tok0 - 128 + row) * QKVW + 1024 + kvh * 64 + c * 8; kv = *(const u32x4*)p; vv = *(const u32x4*)(p + 256); }
            *(LAS u32x4*)(Ks + ks_off(row, c)) = kv; *(LAS u32x4*)(Vs + vs_off(row, c)) = vv; }
        __syncthreads();
        const int hq = kvh * 4 + g;
        const float slope2 = __builtin_amdgcn_exp2f(-0.5f * (float)(hq + 1)) * LOG2E, sink2 = sinks[hq] * LOG2E;
#pragma unroll 1
        for (int sub = 0; sub < 2; ++sub) {
            const int r0 = half * 64 + sub * 32, c0 = r0 >> 5, r = r0 + ql;
            const bf16_t* qp = QKV + (size_t)(tok0 + r) * QKVW + hq * 64 + 8 * h;
            bf16x8 qf[4];
#pragma unroll
            for (int kk = 0; kk < 4; ++kk) qf[kk] = *(const bf16x8*)(qp + 16 * kk);
            const LAS unsigned char* kb0 = Ks + c0 * 4096 + ks_off(ql, 0 + h); const LAS unsigned char* kb1 = Ks + c0 * 4096 + ks_off(ql, 2 + h);
            const LAS unsigned char* kb2 = Ks + c0 * 4096 + ks_off(ql, 4 + h); const LAS unsigned char* kb3 = Ks + c0 * 4096 + ks_off(ql, 6 + h);
            f32x16 S[5];
#pragma unroll
            for (int ck = 0; ck < 5; ++ck) {
#pragma unroll
                for (int i = 0; i < 16; ++i) S[ck][i] = 0.f;
                S[ck] = __builtin_amdgcn_mfma_f32_32x32x16_bf16(*(const LAS bf16x8*)(kb0 + 4096 * ck), qf[0], S[ck], 0, 0, 0);
                S[ck] = __builtin_amdgcn_mfma_f32_32x32x16_bf16(*(const LAS bf16x8*)(kb1 + 4096 * ck), qf[1], S[ck], 0, 0, 0);
                S[ck] = __builtin_amdgcn_mfma_f32_32x32x16_bf16(*(const LAS bf16x8*)(kb2 + 4096 * ck), qf[2], S[ck], 0, 0, 0);
                S[ck] = __builtin_amdgcn_mfma_f32_32x32x16_bf16(*(const LAS bf16x8*)(kb3 + 4096 * ck), qf[3], S[ck], 0, 0, 0);
            }
            const int bd = 128 + ql - 4 * h, jb = 32 * c0 + 4 * h; const float nb = -slope2 * (float)bd;
            float mx = sink2;
#pragma unroll
            for (int ck = 0; ck < 5; ++ck)
#pragma unroll
                for (int i = 0; i < 16; ++i) { const int kc = 32 * ck + (i & 3) + 8 * (i >> 2);
                    const bool valid = (kc <= bd) && (kc > bd - 128) && ((n > 0) || (jb + kc >= 128));
                    const float s = valid ? (S[ck][i] + nb + slope2 * (float)kc) : -1e30f; S[ck][i] = s; mx = fmaxf(mx, s); }
            mx = fmaxf(mx, __shfl_xor(mx, 32));
            float l = 0.f;
            bf16x8 pf[5][2];
#pragma unroll
            for (int ck = 0; ck < 5; ++ck)
#pragma unroll
                for (int s = 0; s < 2; ++s) { float p[8];
#pragma unroll
                    for (int i = 0; i < 8; ++i) { p[i] = __builtin_amdgcn_exp2f(S[ck][8 * s + i] - mx); l += p[i]; }
                    u32x4 pw; pw.x = pk2(p[0], p[1]); pw.y = pk2(p[2], p[3]); pw.z = pk2(p[4], p[5]); pw.w = pk2(p[6], p[7]);
                    pf[ck][s] = __builtin_bit_cast(bf16x8, pw); }
            l += __shfl_xor(l, 32); l += __builtin_amdgcn_exp2f(sink2 - mx);
            const float inv = 1.0f / l;
            f32x16 o0, o1;
#pragma unroll
            for (int i = 0; i < 16; ++i) { o0[i] = 0.f; o1[i] = 0.f; }
            const unsigned vb0 = (unsigned)(size_t)Vs + c0 * 4096 + vs_off(4 * h + tq, 2 * blk + (tp >> 1)) + 8 * (tp & 1);
            const unsigned vb1 = (unsigned)(size_t)Vs + c0 * 4096 + vs_off(4 * h + tq, 4 + 2 * blk + (tp >> 1)) + 8 * (tp & 1);
#define ATT_PV(ck, s) do { s16x4 lo0, hi0, lo1, hi1; tr_read4<4096 * (ck) + 2048 * (s)>(lo0, hi0, lo1, hi1, vb0, vb1); \
                const bf16x8 v0 = __builtin_shufflevector(lo0, hi0, 0, 1, 2, 3, 4, 5, 6, 7), v1 = __builtin_shufflevector(lo1, hi1, 0, 1, 2, 3, 4, 5, 6, 7); \
                o0 = __builtin_amdgcn_mfma_f32_32x32x16_bf16(v0, pf[ck][s], o0, 0, 0, 0); o1 = __builtin_amdgcn_mfma_f32_32x32x16_bf16(v1, pf[ck][s], o1, 0, 0, 0); } while (0)
            ATT_PV(0, 0); ATT_PV(0, 1); ATT_PV(1, 0); ATT_PV(1, 1); ATT_PV(2, 0); ATT_PV(2, 1); ATT_PV(3, 0); ATT_PV(3, 1); ATT_PV(4, 0); ATT_PV(4, 1);
#undef ATT_PV
            bf16_t* op = O + (size_t)(tok0 + r) * D + hq * 64 + 4 * h;
#pragma unroll
            for (int g4 = 0; g4 < 4; ++g4) {
                u32x2 w0; w0.x = pk2(o0[4 * g4 + 0] * inv, o0[4 * g4 + 1] * inv); w0.y = pk2(o0[4 * g4 + 2] * inv, o0[4 * g4 + 3] * inv);
                u32x2 w1; w1.x = pk2(o1[4 * g4 + 0] * inv, o1[4 * g4 + 1] * inv); w1.y = pk2(o1[4 * g4 + 2] * inv, o1[4 * g4 + 3] * inv);
                *(u32x2*)(op + 8 * g4) = w0; *(u32x2*)(op + 32 + 8 * g4) = w1; }
        }
    }
}

__device__ __forceinline__ void pool_phase(LAS unsigned char* lds, const float* X, const float* gain, bf16_t* P, int G, int bid) {
    const int tid = opaque_tid(), lane = tid & 63, wid = __builtin_amdgcn_readfirstlane(tid >> 6);
    LAS float* rs = (LAS float*)lds;
    const int q = tid & 255, half = tid >> 8, w = 2 << (q >> 6), base = 64 * half;
    const f32x4 gn = *(const f32x4*)(gain + 4 * q);
    for (int ch = bid; ch < T / 128; ch += G) {
        const int row0 = ch * 128, spos0 = row0 & (SEQ - 1), halo = spos0 ? 16 : 0;
        __syncthreads();
        for (int i = -halo + 2 * wid; i < 128; i += 16) {
            const f32x4* xa = (const f32x4*)(X + (size_t)(row0 + i) * D) + lane; const f32x4* xb = (const f32x4*)(X + (size_t)(row0 + i + 1) * D) + lane;
            f32x4 va[4], vb[4]; float sa = 0.f, sb = 0.f;
#pragma unroll
            for (int j = 0; j < 4; ++j) { va[j] = xa[64 * j]; vb[j] = xb[64 * j]; }
#pragma unroll
            for (int j = 0; j < 4; ++j) { sa += (va[j].x * va[j].x + va[j].y * va[j].y) + (va[j].z * va[j].z + va[j].w * va[j].w); sb += (vb[j].x * vb[j].x + vb[j].y * vb[j].y) + (vb[j].z * vb[j].z + vb[j].w * vb[j].w); }
            sa = wave_sum(sa); sb = wave_sum(sb);
            if (lane == 0) { rs[i + 16] = 1.0f / sqrtf(sa * (1.f / D) + RMS_EPS); rs[i + 17] = 1.0f / sqrtf(sb * (1.f / D) + RMS_EPS); } }
        __syncthreads();
        const int rmin = -halo;
        f32x4 S = (f32x4){0.f, 0.f, 0.f, 0.f};
        const float* xc = X + (size_t)row0 * D + 4 * q;
#pragma unroll 1
        for (int rb = base - 16; rb < base + 64; rb += 8) {
            f32x4 cur[8], old[8];
#pragma unroll
            for (int k = 0; k < 8; ++k) { const int r = rb + k, rc = r < rmin ? rmin : r, ro = (r - w) < rmin ? rmin : (r - w);
                cur[k] = *(const f32x4*)(xc + (long)rc * D); old[k] = *(const f32x4*)(xc + (long)ro * D); }
#pragma unroll
            for (int k = 0; k < 8; ++k) { const int r = rb + k, rc = r < rmin ? rmin : r, ro = (r - w) < rmin ? rmin : (r - w);
                const bool in = (r >= base - (w - 1)) && (r >= rmin); const bool out = (r >= base + 1) && (r - w >= rmin);
                const f32x4 hv = cur[k] * rs[rc + 16] * gn, ho = old[k] * rs[ro + 16] * gn;
                if (in) S += hv;
                if (out) S -= ho;
                if (r >= base) { const int pos = spos0 + r + 1; const float inv = 1.0f / (float)(pos < w ? pos : w); const f32x4 pv = S * inv - hv;
                    u32x2 o; o.x = pk2(pv.x, pv.y); o.y = pk2(pv.z, pv.w); *(u32x2*)(P + (size_t)(row0 + r) * D + 4 * q) = o; } }
        }
    }
}

__device__ __forceinline__ void router_phase(LAS unsigned char* lds, volatile LAS unsigned* MISC, const float* X, const float* gain, const float* wr, bf16_t* H,
                                             unsigned* gcnt, int* list, float* gsort, int* tokinfo, int G, int bid) {
    const int tid = opaque_tid(), lane = tid & 63, wid = __builtin_amdgcn_readfirstlane(tid >> 6);
    LAS float* wl = (LAS float*)lds;
    __syncthreads();
    for (int i = tid; i < D * NE / 4; i += 512) ((LAS f32x4*)wl)[i] = ((const f32x4*)wr)[i];
    f32x4 gn[4];
#pragma unroll
    for (int j = 0; j < 4; ++j) gn[j] = ((const f32x4*)gain)[lane + 64 * j];
    volatile LAS unsigned* lcnt = MISC + 32; volatile LAS unsigned* lbase = MISC + 40;
    for (int ch = bid; ch < T / 128; ch += G) {
        if (tid < 8) lcnt[tid] = 0u;
        __syncthreads();
        int me1 = 0, me2 = 0; float mg1 = 0.f, mg2 = 0.f;
        f32x4 vn[4];
        { const f32x4* xr = (const f32x4*)(X + (size_t)(ch * 128 + wid * 16) * D) + lane;
#pragma unroll
          for (int j = 0; j < 4; ++j) vn[j] = xr[64 * j]; }
#pragma unroll 1
        for (int i = 0; i < 16; ++i) {
            const int t = ch * 128 + wid * 16 + i;
            f32x4 v[4]; float s = 0.f;
#pragma unroll
            for (int j = 0; j < 4; ++j) v[j] = vn[j];
            { const f32x4* xr = (const f32x4*)(X + (size_t)(i < 15 ? t + 1 : t) * D) + lane;
#pragma unroll
              for (int j = 0; j < 4; ++j) vn[j] = xr[64 * j]; }
#pragma unroll
            for (int j = 0; j < 4; ++j) s += (v[j].x * v[j].x + v[j].y * v[j].y) + (v[j].z * v[j].z + v[j].w * v[j].w);
            const float rstd = 1.0f / sqrtf(wave_sum(s) * (1.f / D) + RMS_EPS);
            float lg[8];
#pragma unroll
            for (int e = 0; e < 8; ++e) lg[e] = 0.f;
            unsigned* o8 = (unsigned*)((unsigned char*)H + (size_t)t * D) + lane;
#pragma unroll
            for (int j = 0; j < 4; ++j) { const f32x4 y = v[j] * rstd * gn[j]; o8[64 * j] = pk4_fp8(y.x, y.y, y.z, y.w);
#pragma unroll
                for (int q = 0; q < 4; ++q) { const LAS f32x4* wp = (const LAS f32x4*)(wl + (size_t)(4 * lane + 256 * j + q) * 8); const f32x4 wa = wp[0], wb = wp[1]; const float yq = y[q];
                    lg[0] += yq * wa.x; lg[1] += yq * wa.y; lg[2] += yq * wa.z; lg[3] += yq * wa.w; lg[4] += yq * wb.x; lg[5] += yq * wb.y; lg[6] += yq * wb.z; lg[7] += yq * wb.w; } }
#pragma unroll
            for (int e = 0; e < 8; ++e) lg[e] = wave_sum(lg[e]);
            int e1 = 0; float v1 = lg[0];
#pragma unroll
            for (int e = 1; e < 8; ++e) if (lg[e] > v1) { v1 = lg[e]; e1 = e; }
            int e2 = -1; float v2 = -3.0e38f;
#pragma unroll
            for (int e = 0; e < 8; ++e) if (e != e1 && lg[e] > v2) { v2 = lg[e]; e2 = e; }
            const float g2 = 1.0f / (1.0f + __expf(v1 - v2)), g1 = 1.0f - g2;
            if (lane == i) { me1 = e1; me2 = e2; mg1 = g1; mg2 = g2; }
        }
        unsigned lp1 = 0, lp2 = 0;
        if (lane < 16) { lp1 = atomicAdd((unsigned*)(MISC + 32 + me1), 1u); lp2 = atomicAdd((unsigned*)(MISC + 32 + me2), 1u); }
        __syncthreads();
        if (tid < 8) lbase[tid] = __hip_atomic_fetch_add(gcnt + 64 * tid, lcnt[tid], RLX_AGENT);
        __syncthreads();
        if (lane < 16) { const int t = ch * 128 + wid * 16 + lane; const int p1 = (int)(lbase[me1] + lp1), p2 = (int)(lbase[me2] + lp2);
            list[me1 * T + p1] = t; gsort[me1 * T + p1] = mg1; list[me2 * T + p2] = t; gsort[me2 * T + p2] = mg2;
            tokinfo[2 * t] = (me1 << 20) | p1; tokinfo[2 * t + 1] = (me2 << 20) | p2; }
        __syncthreads();
    }
}
__device__ __forceinline__ void moe_tiles(volatile LAS int* tb, unsigned* gcnt) {
    __syncthreads();
    if (threadIdx.x == 0) { int a = 0;
        for (int e = 0; e < 8; ++e) { const int c = (int)__hip_atomic_load(gcnt + 64 * e, RLX_AGENT); tb[e] = a; tb[16 + e] = c; a += (c + 255) >> 8; }
        tb[8] = a; }
    __syncthreads();
}
__device__ __forceinline__ void combine_row_load(volatile LAS int* tb, const float* X, const bf16_t* Y, const int* tokinfo, int t, f32x4 (&x)[4], u32x2 (&a)[4], u32x2 (&b)[4], int lane) {
    const int i0 = tokinfo[2 * t], i1 = tokinfo[2 * t + 1];
    const int s0 = tb[i0 >> 20] * 256 + (i0 & 0xFFFFF), s1 = tb[i1 >> 20] * 256 + (i1 & 0xFFFFF);
    const f32x4* xr = (const f32x4*)(X + (size_t)t * D) + lane; const u32x2* y0 = (const u32x2*)(Y + (size_t)s0 * D) + lane; const u32x2* y1 = (const u32x2*)(Y + (size_t)s1 * D) + lane;
#pragma unroll
    for (int j = 0; j < 4; ++j) { x[j] = xr[64 * j]; a[j] = y0[64 * j]; b[j] = y1[64 * j]; }
}
__device__ __forceinline__ void combine_row_store(float* X, int t, f32x4 (&x)[4], const u32x2 (&a)[4], const u32x2 (&b)[4], const f32x4 (&gn)[4], int lane) {
    float s = 0.f;
#pragma unroll
    for (int j = 0; j < 4; ++j) {
        x[j].x += __uint_as_float(a[j].x << 16) + __uint_as_float(b[j].x << 16); x[j].y += __uint_as_float(a[j].x & 0xFFFF0000u) + __uint_as_float(b[j].x & 0xFFFF0000u);
        x[j].z += __uint_as_float(a[j].y << 16) + __uint_as_float(b[j].y << 16); x[j].w += __uint_as_float(a[j].y & 0xFFFF0000u) + __uint_as_float(b[j].y & 0xFFFF0000u);
        s += (x[j].x * x[j].x + x[j].y * x[j].y) + (x[j].z * x[j].z + x[j].w * x[j].w); }
    const float rstd = 1.0f / sqrtf(wave_sum(s) * (1.f / D) + RMS_EPS);
    f32x4* xr = (f32x4*)(X + (size_t)t * D) + lane;
#pragma unroll
    for (int j = 0; j < 4; ++j) xr[64 * j] = x[j] * rstd * gn[j];
}
__device__ __forceinline__ void combine_phase(volatile LAS int* tb, float* X, const bf16_t* Y, const int* tokinfo, const float* gain, int G, int bid) {
    const int tid = opaque_tid(), lane = tid & 63, gw = bid * 8 + __builtin_amdgcn_readfirstlane(tid >> 6), ngw = G * 8;
    f32x4 gn[4];
#pragma unroll
    for (int j = 0; j < 4; ++j) gn[j] = ((const f32x4*)gain)[lane + 64 * j];
    for (int t = gw; t < T; t += 2 * ngw) {
        const int t1 = t + ngw; const bool two = t1 < T; const int tb1 = two ? t1 : t;
        f32x4 xa[4], xb[4]; u32x2 aa[4], ab[4], ba[4], bb[4];
        combine_row_load(tb, X, Y, tokinfo, t, xa, aa, ab, lane);
        combine_row_load(tb, X, Y, tokinfo, tb1, xb, ba, bb, lane);
        combine_row_store(X, t, xa, aa, ab, gn, lane);
        if (two) combine_row_store(X, t1, xb, ba, bb, gn, lane);
    }
}

constexpr int NPHASE = 10 + 2 * NPASS + 1;
struct Args { const float* in[18]; float* out; unsigned char* ws; int ph_lo, ph_hi; };
__global__ void __launch_bounds__(512, 2) trunk_fwd(Args args) {
    extern __shared__ __attribute__((aligned(16))) unsigned char lds_raw[];
    LAS unsigned char* lds = (LAS unsigned char*)lds_raw;
    volatile LAS unsigned* MISC = (volatile LAS unsigned*)(lds + MISC_OFF);
    const int tid = threadIdx.x;
    const int G = gridDim.x, bid = blockIdx.x;
    unsigned char* ws = args.ws;
    unsigned* ctl = (unsigned*)(ws + WS_CTL);
    for (int u = tid; u < (LDS_BYTES - MISC_OFF) / 4; u += 512) MISC[u] = 0u;
    __syncthreads();
    if (tid < 18) { const unsigned long long p = (unsigned long long)args.in[tid]; MISC[64 + 2 * tid] = (unsigned)p; MISC[65 + 2 * tid] = (unsigned)(p >> 32); }
    __syncthreads();
#define INP(k) ((const float*)(((unsigned long long)(unsigned)__builtin_amdgcn_readfirstlane((int)MISC[65 + 2 * (k)]) << 32) | (unsigned long long)(unsigned)__builtin_amdgcn_readfirstlane((int)MISC[64 + 2 * (k)])))
#if MK_PER_PHASE
#define GRID_BAR() do { } while (0)
#else
    XcdBarrier bar = xcd_barrier_post(ctl + CW_BAR, MISC);
#define GRID_BAR() xcd_barrier(bar)
#endif
    const float* x_in = INP(0); float* out = args.out;
    bf16_t* Wqkv = (bf16_t*)(ws + WS_WQKV); bf16_t* Wo = (bf16_t*)(ws + WS_WO); bf16_t* Wgu = (bf16_t*)(ws + WS_WGU); bf16_t* Wd = (bf16_t*)(ws + WS_WD); bf16_t* Wp = (bf16_t*)(ws + WS_WP);
    unsigned char* Mgu = ws + WS_MGU; unsigned char* Md = ws + WS_MD;
    bf16_t* HB = (bf16_t*)(ws + WS_HB); bf16_t* QKV = (bf16_t*)(ws + WS_B); bf16_t* ACT = (bf16_t*)(ws + WS_B); bf16_t* Yb = (bf16_t*)(ws + WS_Y); unsigned char* MACT = ws + WS_MACT;
    int* list = (int*)(ws + WS_LIST); float* gsort = (float*)(ws + WS_GSORT); int* tokinfo = (int*)(ws + WS_TOKINFO);
    unsigned* gcnt = ctl + CW_CNT;
    volatile LAS int* tb = (volatile LAS int*)(MISC + 8);
    const int lo = args.ph_lo, hi = args.ph_hi;
#ifndef PHMASK
#define PHMASK 0xFFFFFFFFu
#endif
#define IN(k) ((((PHMASK) >> ((k) < 10 ? (k) : (10 + (((k) - 10) & 1)))) & 1u) && lo <= (k) && (k) < hi)
#define SEAM(k) do { if (IN(k) && IN((k) + 1)) GRID_BAR(); } while (0)

    for (int rep = 0; rep < REPS(0); ++rep) { if (rep) GRID_BAR(); if (IN(0)) {
        const int tid0 = opaque_tid(), lane = tid0 & 63, wave = __builtin_amdgcn_readfirstlane(tid0 >> 6), gw = bid * 8 + wave, ngw = G * 8;
        LAS float* scr = (LAS float*)(lds + wave * 16640);
        constexpr int I_QKV = 16 * 24, I_O = 16 * 16, I_G = 16 * 44, I_D = 44 * 16, I_P = 4 * 16, I_MG = 16 * 56, I_MD = 56 * 16;
        constexpr int NITEMS = I_QKV + I_O + 2 * I_G + I_D + I_P + NE * (2 * I_MG + I_MD);
        auto decode = [&](int item, TItem& t) {
            int it = item, inter = 0, ioff = 0; t.f8 = 0;
            if (it < I_QKV) { t.src = INP(2); t.dst = Wqkv; t.K = D; t.N = QKVW; }
            else if ((it -= I_QKV) < I_O) { t.src = INP(4); t.dst = Wo; t.K = D; t.N = D; }
            else if ((it -= I_O) < I_G) { t.src = INP(6); t.dst = Wgu; t.K = D; t.N = DFF; inter = 1; }
            else if ((it -= I_G) < I_G) { t.src = INP(7); t.dst = Wgu; t.K = D; t.N = DFF; inter = 1; ioff = 128; }
            else if ((it -= I_G) < I_D) { t.src = INP(8); t.dst = Wd; t.K = DFF; t.N = D; }
            else if ((it -= I_D) < I_P) { const int g = it / 16; it %= 16; t.src = INP(10) + (size_t)g * 256 * 256; t.dst = Wp + (size_t)g * 256 * 256; t.K = 256; t.N = 256; }
            else { it -= I_P; const int per = 2 * I_MG + I_MD, e = it / per; it %= per; t.f8 = 1;
                if (it < I_MG) { t.src = INP(14) + (size_t)e * D * DFE; t.dst = Mgu + (size_t)e * 2 * DFE * D; t.K = D; t.N = DFE; inter = 1; }
                else if ((it -= I_MG) < I_MG) { t.src = INP(15) + (size_t)e * D * DFE; t.dst = Mgu + (size_t)e * 2 * DFE * D; t.K = D; t.N = DFE; inter = 1; ioff = 128; }
                else { it -= I_MG; t.src = INP(16) + (size_t)e * DFE * D; t.dst = Md + (size_t)e * D * DFE; t.K = DFE; t.N = D; } }
            const int nnb = t.N / 64, kb = it / nnb, nb = it % nnb; t.k0 = kb * 64; t.n0 = nb * 64;
            t.drow0 = inter ? ((t.n0 >> 7) * 256 + ioff + (t.n0 & 127)) : t.n0;
        };
        if (gw < NITEMS) {
            TItem cur, nxt; f32x4 r[16]; int item = gw;
            decode(item, cur); titem_load(cur, r, lane);
            for (;;) {
                titem_to_lds(r, scr, lane);
                const int ni = item + ngw; const bool has = ni < NITEMS;
                if (has) { decode(ni, nxt); titem_load(nxt, r, lane); }
                LDS_WAIT(); asm volatile("" ::: "memory");
                titem_store(cur, scr, lane);
                LDS_WAIT(); asm volatile("" ::: "memory");
                if (!has) break;
                cur = nxt; item = ni;
            }
        }
        rms_phase(x_in, INP(1), HB, G, bid);
    }
    }
    SEAM(0);
    for (int rep = 0; rep < REPS(1); ++rep) { if (rep) GRID_BAR(); if (IN(1)) {
        pg8::DenseOrder S{(const char*)HB, (const char*)Wqkv, 2 * D, 2 * D, T / 256, QKVW / 256, G, bid, 0}; pg8::EpiQKV E{QKV};
        pg8::gemm_phase<pg8::EpiQKV, pg8::DenseOrder, false, true, true, false>(lds, S, E, 2 * D, 2 * D, 2 * D);
    }
    }
    SEAM(1);
    for (int rep = 0; rep < REPS(2); ++rep) { if (rep) GRID_BAR(); if (IN(2)) attn_phase(lds, QKV, HB, INP(3), G, bid);
    }
    SEAM(2);
    for (int rep = 0; rep < REPS(3); ++rep) { if (rep) GRID_BAR(); if (IN(3)) {
        pg8::DenseOrder S{(const char*)HB, (const char*)Wo, 2 * D, 2 * D, T / 256, D / 256, G, bid, 0}; pg8::EpiResF32 E{x_in, out, nullptr};
        pg8::gemm_phase<pg8::EpiResF32, pg8::DenseOrder, false, true, true, false>(lds, S, E, 2 * D, 2 * D, 2 * D);
    }
    }
    SEAM(3);
    for (int rep = 0; rep < REPS(4); ++rep) { if (rep) GRID_BAR(); if (IN(4)) rms_phase(out, INP(5), HB, G, bid);
    }
    SEAM(4);
    for (int rep = 0; rep < REPS(5); ++rep) { if (rep) GRID_BAR(); if (IN(5)) {
        pg8::DenseOrder S{(const char*)HB, (const char*)Wgu, 2 * D, 2 * D, T / 256, 2 * DFF / 256, G, bid, 0}; pg8::EpiSwiGLU<false> E{(unsigned char*)ACT, 2 * DFF, 0};
        pg8::gemm_phase<pg8::EpiSwiGLU<false>, pg8::DenseOrder, false, true, true, false>(lds, S, E, 2 * D, 2 * D, 2 * D);
    }
    }
    SEAM(5);
    if (IN(6)) {
        pg8::DenseOrder S{(const char*)ACT, (const char*)Wd, 2 * DFF, 2 * DFF, T / 256, D / 256, G, bid, 0}; pg8::EpiResF32 E{out, out, nullptr};
        pg8::gemm_phase<pg8::EpiResF32, pg8::DenseOrder, false, true, true, false>(lds, S, E, 2 * DFF, 2 * DFF, 2 * DFF);
    }
    SEAM(6);
    for (int rep = 0; rep < REPS(7); ++rep) { if (rep) GRID_BAR(); if (IN(7)) pool_phase(lds, out, INP(9), HB, G, bid);
    }
    SEAM(7);
    if (IN(8)) {
        pg8::DenseOrder S{(const char*)HB, (const char*)Wp, 2 * D, 512, T / 256, 4, G, bid, 1}; pg8::EpiResF32 E{out, out, INP(11)};
        pg8::gemm_phase<pg8::EpiResF32, pg8::DenseOrder, false, true, true, false>(lds, S, E, 512, 2 * D, 512);
    }
    SEAM(8);
    if (IN(9)) router_phase(lds, MISC, out, INP(12), INP(13), HB, gcnt, list, gsort, tokinfo, G, bid);
    SEAM(9);
    if (hi > 10) moe_tiles(tb, gcnt);
    {
        const int Gt = tb[8], TP = (Gt + NPASS - 1) / NPASS;
#pragma unroll 1
        for (int p = 0; p < NPASS; ++p) {
            const int t0 = p * TP, t1 = (t0 + TP < Gt) ? t0 + TP : Gt, ntile = t1 - t0;
            for (int rep = 0; rep < REPS(10); ++rep) { if (rep) GRID_BAR();
            if (IN(10 + 2 * p) && ntile > 0) {
                pg8::MoeOrder S{(const char*)HB, (const char*)Mgu, D, D, ntile, 2 * DFE / 256, G, bid, t0, (size_t)2 * DFE * D, tb, list, 1}; pg8::EpiSwiGLU<true> E{MACT, DFE, t0};
                pg8::gemm_phase<pg8::EpiSwiGLU<true>, pg8::MoeOrder, true, true, true, true>(lds, S, E, D, D, D);
            }
            }
            SEAM(10 + 2 * p);
            for (int rep = 0; rep < REPS(11); ++rep) { if (rep) GRID_BAR();
            if (IN(11 + 2 * p) && ntile > 0) {
                pg8::MoeOrder S{(const char*)MACT, (const char*)Md, DFE, DFE, ntile, D / 256, G, bid, t0, (size_t)D * DFE, tb, list, 0}; pg8::EpiMoeDown E{Yb, gsort, tb};
                pg8::gemm_phase<pg8::EpiMoeDown, pg8::MoeOrder, false, true, true, true>(lds, S, E, DFE, DFE, DFE);
            }
            }
            SEAM(11 + 2 * p);
        }
    }
    if (IN(NPHASE - 1)) combine_phase(tb, out, Yb, tokinfo, INP(17), G, bid);
#undef IN
#undef SEAM
#undef INP
}

extern "C" void kernel_launch(void* const* d_in, const int* in_sizes, int n_in, void* d_out, int out_size, void* d_ws, size_t ws_size, hipStream_t stream) {
    static int grid = 0;
    if (grid == 0) {
        if (n_in != 18 || in_sizes[0] != T * D || out_size != T * D || ws_size < WS_END) { fprintf(stderr, "kernel_launch: unexpected shapes / workspace (%d inputs, ws %zu < %zu)\n", n_in, ws_size, (size_t)WS_END); grid = -1; return; }
        int dev = 0, cus = 0, per_cu = 0;
        if (hipGetDevice(&dev) != hipSuccess || hipDeviceGetAttribute(&cus, hipDeviceAttributeMultiprocessorCount, dev) != hipSuccess) { grid = -1; return; }
        if (hipFuncSetAttribute((const void*)trunk_fwd, hipFuncAttributeMaxDynamicSharedMemorySize, LDS_BYTES) != hipSuccess) { fprintf(stderr, "kernel_launch: hipFuncSetAttribute failed\n"); grid = -1; return; }
        if (hipOccupancyMaxActiveBlocksPerMultiprocessor(&per_cu, (const void*)trunk_fwd, 512, LDS_BYTES) != hipSuccess || per_cu < 1) fprintf(stderr, "kernel_launch: occupancy query reports %d\n", per_cu);
        (void)hipGetLastError();
        grid = cus;
    }
    if (grid < 0) return;
    if (hipMemsetAsync((char*)d_ws + WS_CTL, 0, CTL_ZERO_BYTES, stream) != hipSuccess) return;
    Args a{};
    for (int i = 0; i < 18; ++i) a.in[i] = (const float*)d_in[i];
    a.out = (float*)d_out; a.ws = (unsigned char*)d_ws;
#if MK_PER_PHASE
    for (int ph = 0; ph < NPHASE; ++ph) { a.ph_lo = ph; a.ph_hi = ph + 1; hipLaunchKernelGGL(trunk_fwd, dim3(grid), dim3(512), LDS_BYTES, stream, a); }
#else
    a.ph_lo = 0; a.ph_hi = NPHASE;
    hipLaunchKernelGGL(trunk_fwd, dim3(grid), dim3(512), LDS_BYTES, stream, a);
#endif
}
```

```cpp
#include <hip/hip_runtime.h>
#include <cstdio>
#include <cstdint>

#ifndef MK_PER_PHASE
#define MK_PER_PHASE 0
#endif

#ifndef PROBE_REPEAT
#define PROBE_REPEAT -1
#endif
#ifndef PROBE_N
#define PROBE_N 2
#endif
#define REPS(k) ((PROBE_REPEAT) == (k) ? (PROBE_N) : 1)
#define LAS __attribute__((address_space(3)))
#define GAS __attribute__((address_space(1)))
typedef unsigned short bf16_t;
typedef short bf16x8 __attribute__((ext_vector_type(8)));
typedef short s16x4 __attribute__((ext_vector_type(4)));
typedef float f32x4 __attribute__((ext_vector_type(4)));
typedef float f32x2 __attribute__((ext_vector_type(2)));
typedef float f32x16 __attribute__((ext_vector_type(16)));
typedef unsigned u32x4 __attribute__((ext_vector_type(4)));
typedef unsigned u32x2 __attribute__((ext_vector_type(2)));
typedef __bf16 bf16v2 __attribute__((ext_vector_type(2)));
typedef int i32x8 __attribute__((ext_vector_type(8)));
typedef int i32x4 __attribute__((ext_vector_type(4)));

constexpr int BATCH = 8, SEQ = 4096, T = BATCH * SEQ, D = 1024, QKVW = 1536, DFF = 2816, NE = 8, DFE = 3584, NHEAD = 16, NKV = 4, HD = 64;
constexpr float RMS_EPS = 1e-5f, LOG2E = 1.4426950408889634f;
constexpr float QSCALE = 0.125f * LOG2E;
constexpr int NPASS = 1, TPMAX = 264, GMAX = 264;

constexpr size_t MiB = 1u << 20;
constexpr size_t WS_CTL = 0, CTL_ZERO_BYTES = 1 * MiB;
constexpr size_t WS_LIST = 1 * MiB;
constexpr size_t WS_GSORT = 2 * MiB;
constexpr size_t WS_TOKINFO = 3 * MiB;
constexpr size_t WS_WQKV = 4 * MiB;
constexpr size_t WS_WO = 7 * MiB;
constexpr size_t WS_WGU = 9 * MiB;
constexpr size_t WS_WD = 20 * MiB;
constexpr size_t WS_WP = 26 * MiB;
constexpr size_t WS_MGU = 27 * MiB;
constexpr size_t WS_MD = 83 * MiB;
constexpr size_t WS_HB = 111 * MiB;
constexpr size_t WS_B = 175 * MiB;
constexpr size_t WS_Y = WS_HB + 32 * MiB, WS_MACT = WS_Y + 132 * MiB;
constexpr size_t WS_END = WS_MACT + (size_t)TPMAX * 256 * DFE;
static_assert(WS_END <= 512 * MiB, "workspace");
static_assert((size_t)GMAX * 256 * D * 2 <= 132 * MiB, "y");
static_assert(WS_MGU + (size_t)NE * 2 * DFE * D <= WS_MD && WS_MD + (size_t)NE * D * DFE <= WS_HB && WS_HB + (size_t)T * D * 2 <= WS_B, "map");
static_assert(WS_B + (size_t)T * DFF * 2 <= 512 * MiB, "act");
constexpr int CW_TMO = 0;
constexpr int CW_BAR = 4096;
constexpr int CW_CNT = 16384;

constexpr int RING_BYTES = 131072;
constexpr int LDS_BYTES = 147456;
constexpr int MISC_OFF = 146432;

#define RLX_AGENT __ATOMIC_RELAXED, __HIP_MEMORY_SCOPE_AGENT
#define LDS_WAIT() asm volatile("s_waitcnt lgkmcnt(0)" ::: "memory")
#define VM_WAIT() asm volatile("s_waitcnt vmcnt(0)" ::: "memory")

__device__ __forceinline__ unsigned pk2(float lo, float hi) { bf16v2 v = {(__bf16)lo, (__bf16)hi}; return __builtin_bit_cast(unsigned, v); }
__device__ __forceinline__ f32x4 unpack4(const u32x2 w) { return (f32x4){__uint_as_float(w.x << 16), __uint_as_float(w.x & 0xFFFF0000u), __uint_as_float(w.y << 16), __uint_as_float(w.y & 0xFFFF0000u)}; }
constexpr float W8_SCALE = 64.0f, W8_INV = 1.0f / 64.0f;
__device__ __forceinline__ unsigned pk4_fp8(float a, float b, float c, float d) {
    unsigned w = 0u; w = (unsigned)__builtin_amdgcn_cvt_pk_fp8_f32(a, b, (int)w, false); w = (unsigned)__builtin_amdgcn_cvt_pk_fp8_f32(c, d, (int)w, true); return w; }
__device__ __forceinline__ int opaque_tid() { int t = threadIdx.x; asm volatile("" : "+v"(t)); return t; }
template <int CTRL> __device__ __forceinline__ float dpp_mov(float v) { return __builtin_bit_cast(float, __builtin_amdgcn_update_dpp(0, __builtin_bit_cast(int, v), CTRL, 0xF, 0xF, true)); }
__device__ __forceinline__ float wave_sum(float v) {
    v += dpp_mov<0xB1>(v);
    v += dpp_mov<0x4E>(v);
    v += dpp_mov<0x141>(v);
    v += dpp_mov<0x140>(v);
    v += __shfl_xor(v, 16); v += __shfl_xor(v, 32);
    return v;
}

#define XB_TMO      128
#define XB_XCNT(j)  (256  + 64 * (j))
#define XB_XSUB(j)  (1280 + 64 * (j))
#define XB_XGEN(j)  (2304 + 64 * (j))
#define XB_TOP      3328
#define XB_TOPGEN   3392
#define XCD_BAR_WORDS 3456
#define XB_SPIN_CAP (1u << 18)
__device__ __forceinline__ unsigned xb_ld(unsigned* p)              { return __hip_atomic_load(p, __ATOMIC_RELAXED, __HIP_MEMORY_SCOPE_AGENT); }
__device__ __forceinline__ unsigned xb_add(unsigned* p, unsigned v) { return __hip_atomic_fetch_add(p, v, __ATOMIC_RELAXED, __HIP_MEMORY_SCOPE_AGENT); }
__device__ __forceinline__ unsigned xb_xcc_id() { return (unsigned)__builtin_amdgcn_s_getreg((3 << 11) | 20) & 0xFu; }
#define XB_SPIN(cond, bar) do { unsigned _sp = 0; while (cond) { __builtin_amdgcn_s_sleep(1); \
    if ((++_sp & 255u) == 0u) { if (xb_ld(&(bar)[XB_TMO])) break; if (_sp > XB_SPIN_CAP) { atomicAdd(&(bar)[XB_TMO], 1u); break; } } } } while (0)
struct XcdBarrier { unsigned* bar; unsigned x; volatile LAS unsigned* st; };
__device__ __forceinline__ XcdBarrier xcd_barrier_post(unsigned* bar, volatile LAS unsigned* st) {
    XcdBarrier b; b.bar = bar; b.x = xb_xcc_id(); b.st = st;
    if (threadIdx.x == 0) (void)xb_add(&bar[XB_XCNT(b.x)], 1u);
    return b;
}
__device__ __forceinline__ void xcd_barrier_complete(unsigned* bar, unsigned x, unsigned& nloc, unsigned& nx) {
    const unsigned G = gridDim.x * gridDim.y * gridDim.z;
    unsigned sum, cnt, mine, sp = 0u;
    for (;;) {
        sum = 0u; cnt = 0u; mine = 0u;
#pragma unroll
        for (unsigned j = 0; j < 16; ++j) { const unsigned c = xb_ld(&bar[XB_XCNT(j)]); sum += c; cnt += (c > 0u) ? 1u : 0u; mine = (j == x) ? c : mine; }
        if (sum == G) break;
        __builtin_amdgcn_s_sleep(1);
        if ((++sp & 255u) == 0u) { if (xb_ld(&bar[XB_TMO])) break; if (sp > XB_SPIN_CAP) { atomicAdd(&bar[XB_TMO], 1u); break; } }
    }
    nloc = mine > 0u ? mine : 1u; nx = cnt > 0u ? cnt : 1u;
}
__device__ __forceinline__ void xcd_barrier(const XcdBarrier& b) {
    asm volatile("s_waitcnt vmcnt(0)" ::: "memory");
    __syncthreads();
    if (threadIdx.x == 0) {
        unsigned* bar = b.bar;
        __builtin_amdgcn_s_waitcnt(0);
        unsigned nloc = b.st[0], nx = b.st[1];
        if (nloc == 0u) { xcd_barrier_complete(bar, b.x, nloc, nx); b.st[0] = nloc; b.st[1] = nx; }
        const unsigned old = xb_add(&bar[XB_XSUB(b.x)], 1u);
        const unsigned gen = old / nloc;
        if (old + 1u == (gen + 1u) * nloc) {
            __builtin_amdgcn_fence(__ATOMIC_RELEASE, "agent");
            asm volatile("s_waitcnt vmcnt(0)" ::: "memory");
            const unsigned og = xb_add(&bar[XB_TOP], 1u);
            const unsigned tg = og / nx;
            if (og + 1u == (tg + 1u) * nx) xb_add(&bar[XB_TOPGEN], 1u);
            else XB_SPIN(xb_ld(&bar[XB_TOPGEN]) == tg, bar);
            __builtin_amdgcn_fence(__ATOMIC_ACQUIRE, "agent");
            xb_add(&bar[XB_XGEN(b.x)], 1u);
            asm volatile("s_waitcnt vmcnt(0)" ::: "memory");
        } else {
            XB_SPIN(xb_ld(&bar[XB_XGEN(b.x)]) == gen, bar);
            __builtin_amdgcn_fence(__ATOMIC_ACQUIRE, "agent");
            asm volatile("s_waitcnt vmcnt(0)" ::: "memory");
        }
    }
    __syncthreads();
}

namespace pg8 {
constexpr int BM = 256, BK = 64, HALF = 128, HTB = HALF * BK * 2, NXCD = 8, WGM = 8;
constexpr int IDX_OFF = 131072;
__device__ __forceinline__ int lds_byte(int r, int c) { const int st = (r >> 4) * 2 + (c >> 5), rr = r & 15, cc = c & 31, ob = rr * 64 + cc * 2; return st * 1024 + (ob ^ (((ob >> 9) & 1) << 5)); }
__device__ __forceinline__ void stage_rc(int b, int& R, int& C) { const int st = b / 1024, sb = b % 1024, swz = sb ^ (((sb >> 9) & 1) << 5); R = (st >> 1) * 16 + swz / 64; C = (st & 1) * 32 + (swz % 64) / 2; }
__device__ __forceinline__ int perm32(int rho) { const int n = rho >> 4, i = rho & 15; return 8 * (i >> 2) + 4 * n + (i & 3); }

struct Unit { int pm, pn, e; };

__device__ __forceinline__ bool tile_of(int i, int G, int c, int nM, int nN, int& pm, int& pn) {
    const int nwg = nM * nN; const int L = i * G + c; if (L >= nwg) return false;
    int wgid = L; { const int q = nwg / NXCD, r = nwg % NXCD, xcd = wgid % NXCD, off = wgid / NXCD; wgid = (xcd < r ? xcd * (q + 1) : r * (q + 1) + (xcd - r) * q) + off; }
    const int nig = WGM * nN, gid = wgid / nig, fm = gid * WGM, gsz = (nM - fm) < WGM ? (nM - fm) : WGM;
    pm = fm + ((wgid % nig) % gsz); pn = (wgid % nig) / gsz; return true;
}
struct DenseOrder {
    const char* A; const char* Bt; int lda, ldb, nM, nN, G, c; int grouped;
    __device__ __forceinline__ bool next(int i, Unit& u) const { u.e = i; return tile_of(i, G, c, nM, nN, u.pm, u.pn); }
    __device__ __forceinline__ const char* a_base(const Unit& u) const { return A + (size_t)u.pm * 256 * lda + (grouped ? u.pn * 512 : 0); }
    __device__ __forceinline__ const char* b_base(const Unit& u) const { return Bt + (size_t)u.pn * 256 * ldb; }
    __device__ __forceinline__ int grow(const Unit&, int) const { return 0; }
    __device__ __forceinline__ const int* gptr(const Unit&, int) const { return nullptr; }
};
struct MoeOrder {
    const char* A; const char* Bt; int lda, ldb, nM, nN, G, c, t0, toff; size_t bstride;
    const volatile LAS int* tb; const int* list; int gather;
    __device__ __forceinline__ bool next(int i, Unit& u) const {
        if (!tile_of(i, G, c, nM, nN, u.pm, u.pn)) return false;
        u.pm += toff; int e = 0;
#pragma unroll
        for (int j = 1; j < 8; ++j) e += (u.pm >= tb[j]) ? 1 : 0;
        u.e = __builtin_amdgcn_readfirstlane(e); return true;
    }
    __device__ __forceinline__ const char* a_base(const Unit& u) const { return gather ? A : A + (size_t)(u.pm - t0) * 256 * lda; }
    __device__ __forceinline__ const char* b_base(const Unit& u) const { return Bt + (size_t)u.e * bstride + (size_t)u.pn * 256 * ldb; }
    __device__ __forceinline__ int grow(const Unit& u, int r) const {
        const int tbe = __builtin_amdgcn_readfirstlane(tb[u.e]), n = __builtin_amdgcn_readfirstlane(tb[16 + u.e]);
        int p = (u.pm - tbe) * 256 + r; p = p < n ? p : n - 1;
        return list[u.e * T + p];
    }
    __device__ __forceinline__ const int* gptr(const Unit& u, int r) const {
        const int tbe = __builtin_amdgcn_readfirstlane(tb[u.e]), n = __builtin_amdgcn_readfirstlane(tb[16 + u.e]);
        int p = (u.pm - tbe) * 256 + r; p = p < n ? p : n - 1;
        return list + u.e * T + p;
    }
};

struct EpiQKV {
    static constexpr bool PERM = true; static constexpr int PROBE_ID = 1;
    bf16_t* O; const float* rstd;
    __device__ __forceinline__ void operator()(const f32x4 (&acc)[2][2][4][2], const Unit& u, int wr, int wc, int fr, int fq) const {
        const int row0 = u.pm * BM + wr * 64 + fr, col0 = u.pn * BM + wc * 32 + 8 * fq; const float sc0 = (u.pn < 4) ? QSCALE : 1.0f;
        float rs[2][4];
#pragma unroll
        for (int ai = 0; ai < 2; ++ai)
#pragma unroll
            for (int m = 0; m < 4; ++m) rs[ai][m] = rstd[row0 + ai * HALF + m * 16];
#pragma unroll
        for (int ai = 0; ai < 2; ++ai)
#pragma unroll
            for (int m = 0; m < 4; ++m) { bf16_t* rowp = O + (size_t)(row0 + ai * HALF + m * 16) * QKVW + col0; const float sc = sc0 * rs[ai][m];
#pragma unroll
                for (int bj = 0; bj < 2; ++bj) { const f32x4 v0 = acc[ai][bj][m][0] * sc, v1 = acc[ai][bj][m][1] * sc;
                    u32x4 w; w.x = pk2(v0[0], v0[1]); w.y = pk2(v0[2], v0[3]); w.z = pk2(v1[0], v1[1]); w.w = pk2(v1[2], v1[3]);
                    *(u32x4*)(rowp + bj * HALF) = w; } }
    }
};
struct EpiResF32 {
    static constexpr bool PERM = true; static constexpr int PROBE_ID = 3;
    const bf16_t* res; bf16_t* out; const float* scale; float* ssq;
    __device__ __forceinline__ void operator()(const f32x4 (&acc)[2][2][4][2], const Unit& u, int wr, int wc, int fr, int fq) const {
        const int row0 = u.pm * BM + wr * 64 + fr, col0 = u.pn * BM + wc * 32 + 8 * fq;
        float sq[2][4];
#pragma unroll
        for (int ai = 0; ai < 2; ++ai)
#pragma unroll
            for (int m = 0; m < 4; ++m) sq[ai][m] = 0.f;
#pragma unroll
        for (int bj = 0; bj < 2; ++bj) {
            f32x4 s0 = (f32x4){1.f, 1.f, 1.f, 1.f}, s1 = s0;
            if (scale) { s0 = *(const f32x4*)(scale + col0 + bj * HALF); s1 = *(const f32x4*)(scale + col0 + bj * HALF + 4); }
#pragma unroll
            for (int ai = 0; ai < 2; ++ai) {
#pragma unroll
                for (int m = 0; m < 4; ++m) { const size_t off = (size_t)(row0 + ai * HALF + m * 16) * D + col0 + bj * HALF; const u32x4 rw = *(const u32x4*)(res + off);
                    const f32x4 o0 = unpack4((u32x2){rw.x, rw.y}) + acc[ai][bj][m][0] * s0, o1 = unpack4((u32x2){rw.z, rw.w}) + acc[ai][bj][m][1] * s1;
                    u32x4 w; w.x = pk2(o0.x, o0.y); w.y = pk2(o0.z, o0.w); w.z = pk2(o1.x, o1.y); w.w = pk2(o1.z, o1.w);
                    *(u32x4*)(out + off) = w;
                    sq[ai][m] += (o0.x * o0.x + o0.y * o0.y) + (o0.z * o0.z + o0.w * o0.w) + (o1.x * o1.x + o1.y * o1.y) + (o1.z * o1.z + o1.w * o1.w); }
                asm volatile("" ::: "memory"); } }
        if (ssq) {
#pragma unroll
            for (int ai = 0; ai < 2; ++ai)
#pragma unroll
                for (int m = 0; m < 4; ++m) { float v = sq[ai][m]; v += __shfl_xor(v, 16); v += __shfl_xor(v, 32);
                    if (fq == 0) ssq[(size_t)(row0 + ai * HALF + m * 16) * 16 + 4 * u.pn + wc] = v; } }
    }
};
__device__ __forceinline__ float silu_mul(float g, float u) { return g * u * __builtin_amdgcn_rcpf(1.0f + __builtin_amdgcn_exp2f(-g * LOG2E)); }
__device__ __forceinline__ f32x2 silu_mul_pk(f32x2 g, f32x2 u) {
    const f32x2 a2 = g * (-LOG2E); f32x2 t; t.x = __builtin_amdgcn_exp2f(a2.x); t.y = __builtin_amdgcn_exp2f(a2.y);
    const f32x2 d = t + 1.0f; f32x2 r; r.x = __builtin_amdgcn_rcpf(d.x); r.y = __builtin_amdgcn_rcpf(d.y);
    return (g * u) * r;
}
__device__ __forceinline__ f32x2 silu_mul64_pk(f32x2 a, f32x2 b) {
    const f32x2 a2 = a * (-LOG2E * W8_INV); f32x2 t; t.x = __builtin_amdgcn_exp2f(a2.x); t.y = __builtin_amdgcn_exp2f(a2.y);
    const f32x2 d = t * 4096.0f + 4096.0f; f32x2 r; r.x = __builtin_amdgcn_rcpf(d.x); r.y = __builtin_amdgcn_rcpf(d.y);
    return (a * b) * r;
}
__device__ __forceinline__ float silu_mul64(float a, float b) { return a * b * __builtin_amdgcn_rcpf(__builtin_fmaf(__builtin_amdgcn_exp2f(a * (-LOG2E * W8_INV)), 4096.0f, 4096.0f)); }
template <bool F8> struct EpiSwiGLU {
    static constexpr bool PERM = true; static constexpr int PROBE_ID = 5;
    unsigned char* O; int ldc, tile0; const float* ssq = nullptr; const LAS float* rtab = nullptr;
    __device__ __forceinline__ void operator()(const f32x4 (&acc)[2][2][4][2], const Unit& u, int wr, int wc, int fr, int fq) const {
        const int row0 = (u.pm - tile0) * BM + wr * 64 + fr, col0 = u.pn * HALF + wc * 32 + 8 * fq;
#pragma unroll
        for (int ai = 0; ai < 2; ++ai)
#pragma unroll
            for (int m = 0; m < 4; ++m) { unsigned char* rowp = O + (size_t)(row0 + ai * HALF + m * 16) * ldc + col0 * (F8 ? 1 : 2);
                f32x4 g0 = acc[ai][0][m][0], g1 = acc[ai][0][m][1], u0 = acc[ai][1][m][0], u1 = acc[ai][1][m][1];
                if constexpr (F8) {
                    const f32x2 p0 = silu_mul64_pk((f32x2){g0[0], g0[1]}, (f32x2){u0[0], u0[1]}), p1 = silu_mul64_pk((f32x2){g0[2], g0[3]}, (f32x2){u0[2], u0[3]});
                    const f32x2 p2 = silu_mul64_pk((f32x2){g1[0], g1[1]}, (f32x2){u1[0], u1[1]}), p3 = silu_mul64_pk((f32x2){g1[2], g1[3]}, (f32x2){u1[2], u1[3]});
                    u32x2 w; w.x = pk4_fp8(p0.x, p0.y, p1.x, p1.y); w.y = pk4_fp8(p2.x, p2.y, p3.x, p3.y);
                    *(u32x2*)rowp = w; }
                else {
                    if (rtab) { const float r = rtab[u.e * 256 + wr * 64 + fr + ai * HALF + m * 16]; g0 *= r; g1 *= r; u0 *= r; u1 *= r; }
                    else if (ssq) { const f32x4* pp = (const f32x4*)(ssq + (size_t)(row0 + ai * HALF + m * 16) * 16); const f32x4 a0 = pp[0], a1 = pp[1], a2 = pp[2], a3 = pp[3];
                        const float sa = ((a0.x + a0.y) + (a0.z + a0.w)) + ((a1.x + a1.y) + (a1.z + a1.w)) + ((a2.x + a2.y) + (a2.z + a2.w)) + ((a3.x + a3.y) + (a3.z + a3.w));
                        const float r = 1.0f / sqrtf(sa * (1.f / D) + RMS_EPS); g0 *= r; g1 *= r; u0 *= r; u1 *= r; }
                    const f32x2 p0 = silu_mul_pk((f32x2){g0[0], g0[1]}, (f32x2){u0[0], u0[1]}), p1 = silu_mul_pk((f32x2){g0[2], g0[3]}, (f32x2){u0[2], u0[3]});
                    const f32x2 p2 = silu_mul_pk((f32x2){g1[0], g1[1]}, (f32x2){u1[0], u1[1]}), p3 = silu_mul_pk((f32x2){g1[2], g1[3]}, (f32x2){u1[2], u1[3]});
                    u32x4 w; w.x = pk2(p0.x, p0.y); w.y = pk2(p1.x, p1.y); w.z = pk2(p2.x, p2.y); w.w = pk2(p3.x, p3.y);
                    *(u32x4*)rowp = w; } }
    }
};
constexpr float Y8_SCALE = 16.0f, Y8_INV = 1.0f / 16.0f;
struct EpiMoeDown {
    static constexpr bool PERM = true; static constexpr int PROBE_ID = 11;
    unsigned char* Y; const float* gsort; const volatile LAS int* tb;
    __device__ __forceinline__ void operator()(const f32x4 (&acc)[2][2][4][2], const Unit& u, int wr, int wc, int fr, int fq) const {
        const int lrow0 = wr * 64 + fr, col0 = u.pn * BM + wc * 32 + 8 * fq; const int p0 = (u.pm - __builtin_amdgcn_readfirstlane(tb[u.e])) * 256, n = __builtin_amdgcn_readfirstlane(tb[16 + u.e]);
#pragma unroll
        for (int ai = 0; ai < 2; ++ai)
#pragma unroll
            for (int m = 0; m < 4; ++m) { const int lr = lrow0 + ai * HALF + m * 16; const int pp = p0 + lr; const float gw = gsort[u.e * T + (pp < n ? pp : n - 1)] * (W8_INV * Y8_SCALE);
                unsigned char* rowp = Y + (size_t)(u.pm * 256 + lr) * D + col0;
#pragma unroll
                for (int bj = 0; bj < 2; ++bj) { const f32x4 v0 = acc[ai][bj][m][0] * gw, v1 = acc[ai][bj][m][1] * gw;
                    u32x2 w; w.x = pk4_fp8(v0[0], v0[1], v0[2], v0[3]); w.y = pk4_fp8(v1[0], v1[1], v1[2], v1[3]);
                    *(u32x2*)(rowp + bj * HALF) = w; } }
    }
};

template <class Epi, class Sched, bool GATHER, bool ALIGN_EPI, bool SP2, bool FP8>
__device__ __forceinline__ void gemm_phase(LAS unsigned char* lds, const Sched& S, const Epi& E, const int Kb, const int lda, const int ldb) {
    int tid_ = threadIdx.x; asm volatile("" : "+v"(tid_));
    const int tid = tid_, wid = __builtin_amdgcn_readfirstlane(tid >> 6), lane = tid & 63, wr = wid >> 2, wc = wid & 3, fr = lane & 15, fq = lane >> 4;
    int nt_ = Kb / 128; asm volatile("" : "+s"(nt_)); const int nt = nt_;
    unsigned voffA[2][2], voffB[2];
#pragma unroll
    for (int i = 0; i < 2; ++i) { int R, C; stage_rc(tid * 16 + i * 8192, R, C); const int Rb = Epi::PERM ? ((R & ~31) + perm32(R & 31)) : R;
        voffA[0][i] = (unsigned)(R * lda + 2 * C); voffA[1][i] = 0u; voffB[i] = (unsigned)(Rb * ldb + 2 * C); }
    constexpr int kstep = BK * 2;
    const int hstepB = HALF * ldb;
    const int hstepA = GATHER ? 0 : HALF * lda;
    const unsigned ldsw = (unsigned)wid * 1024u;
    const int aoff = lds_byte(wr * 64 + fr, fq * 8), boff = lds_byte(wc * 32 + fr, fq * 8);
#define PG8_SA(b, h) (((b) * 2 + (h)) * HTB)
#define PG8_SB(b, h) ((4 + (b) * 2 + (h)) * HTB)
#define PG8_STAGE(bufoff, gbase, voff) do { _Pragma("unroll") for (int _i = 0; _i < 2; ++_i) \
        __builtin_amdgcn_global_load_lds((const unsigned*)((const char*)(gbase) + (voff)[_i]), (LAS unsigned*)(lds + (bufoff) + ldsw + _i * 8192), 16, 0, 0); } while (0)
#define PG8_LDA(dst, b, h) do { _Pragma("unroll") for (int m = 0; m < 4; ++m) { const LAS i32x4* _p = (const LAS i32x4*)(lds + PG8_SA(b, h) + aoff + m * 2048); const i32x4 _lo = _p[0], _hi = _p[64]; \
        dst[m] = __builtin_shufflevector(_lo, _hi, 0, 1, 2, 3, 4, 5, 6, 7); } } while (0)
#define PG8_LDB(dst, b, h) do { _Pragma("unroll") for (int n = 0; n < 2; ++n) { const LAS i32x4* _p = (const LAS i32x4*)(lds + PG8_SB(b, h) + boff + n * 2048); const i32x4 _lo = _p[0], _hi = _p[64]; \
        dst[n] = __builtin_shufflevector(_lo, _hi, 0, 1, 2, 3, 4, 5, 6, 7); } } while (0)
#define PG8_MMA(ai, bj, At, Bt) do { __builtin_amdgcn_s_setprio(1); _Pragma("unroll") for (int m = 0; m < 4; ++m) _Pragma("unroll") for (int n = 0; n < 2; ++n) { \
        if constexpr (FP8) { asm volatile("v_mfma_scale_f32_16x16x128_f8f6f4 %0, %1, %2, %0, %3, %3 op_sel_hi:[0,0,0]" : "+v"(acc[ai][bj][m][n]) : "v"(Bt[n]), "v"(At[m]), "v"(one8)); } \
        else { acc[ai][bj][m][n] = __builtin_amdgcn_mfma_f32_16x16x32_bf16(__builtin_bit_cast(bf16x8, __builtin_shufflevector(Bt[n], Bt[n], 0, 1, 2, 3)), __builtin_bit_cast(bf16x8, __builtin_shufflevector(At[m], At[m], 0, 1, 2, 3)), acc[ai][bj][m][n], 0, 0, 0); \
               acc[ai][bj][m][n] = __builtin_amdgcn_mfma_f32_16x16x32_bf16(__builtin_bit_cast(bf16x8, __builtin_shufflevector(Bt[n], Bt[n], 4, 5, 6, 7)), __builtin_bit_cast(bf16x8, __builtin_shufflevector(At[m], At[m], 4, 5, 6, 7)), acc[ai][bj][m][n], 0, 0, 0); } } \
        __builtin_amdgcn_s_setprio(0); } while (0)
#define PG8_WAIT_V(n) asm volatile("s_waitcnt vmcnt(" #n ")" ::: "memory")
#define PG8_WAIT_L(n) asm volatile("s_waitcnt lgkmcnt(" #n ")" ::: "memory")
#define PG8_BAR __builtin_amdgcn_s_barrier()
#define PG8_SCHED __builtin_amdgcn_sched_barrier(0)
#define PG8_GOFF(dst, unit) do { _Pragma("unroll") for (int _i = 0; _i < 2; ++_i) { int _R, _C; stage_rc(tid * 16 + _i * 8192, _R, _C); \
        dst[0][_i] = (unsigned)(S.grow(unit, _R) * lda + 2 * _C); dst[1][_i] = (unsigned)(S.grow(unit, _R + HALF) * lda + 2 * _C); } } while (0)
    Unit cur, nxt; int ui = 0;
    if (!S.next(0, cur)) return;
    f32x4 acc[2][2][4][2];
#pragma unroll
    for (int a = 0; a < 2; ++a)
#pragma unroll
        for (int b = 0; b < 2; ++b)
#pragma unroll
            for (int m = 0; m < 4; ++m)
#pragma unroll
                for (int n = 0; n < 2; ++n) acc[a][b][m][n] = (f32x4){0.f, 0.f, 0.f, 0.f};
    int one8 = 0x7F7F7F7F; asm volatile("" : "+v"(one8));
    i32x8 At[4], B0[2], B1[2];
    const char* cA = S.a_base(cur); const char* cB = S.b_base(cur);
    if constexpr (GATHER) { PG8_GOFF(voffA, cur); }
    if constexpr (SP2) {
        PG8_STAGE(PG8_SB(0, 0), cB, voffB); PG8_STAGE(PG8_SB(0, 1), cB + hstepB, voffB); PG8_STAGE(PG8_SA(0, 0), cA, voffA[0]); PG8_STAGE(PG8_SA(0, 1), cA + hstepA, voffA[GATHER ? 1 : 0]);
        if (wr == 1) PG8_BAR;
        PG8_WAIT_V(2); PG8_BAR;
        PG8_STAGE(PG8_SB(1, 0), cB + kstep, voffB); PG8_STAGE(PG8_SA(1, 0), cA + kstep, voffA[0]); PG8_STAGE(PG8_SB(1, 1), cB + hstepB + kstep, voffB);
        PG8_WAIT_V(6); PG8_BAR;
    } else {
        PG8_STAGE(PG8_SB(0, 0), cB, voffB); PG8_STAGE(PG8_SA(0, 0), cA, voffA[0]); PG8_STAGE(PG8_SB(0, 1), cB + hstepB, voffB); PG8_STAGE(PG8_SA(0, 1), cA + hstepA, voffA[GATHER ? 1 : 0]);
        if (wr == 1) PG8_BAR;
        PG8_WAIT_V(4); PG8_BAR;
        PG8_STAGE(PG8_SB(1, 0), cB + kstep, voffB); PG8_STAGE(PG8_SA(1, 0), cA + kstep, voffA[0]); PG8_STAGE(PG8_SB(1, 1), cB + hstepB + kstep, voffB);
        PG8_WAIT_V(6); PG8_BAR;
    }
    for (;;) {
        const bool has_next = S.next(ui + 1, nxt);
        const char* nA = has_next ? S.a_base(nxt) : cA; const char* nB = has_next ? S.b_base(nxt) : cB;
        if constexpr (GATHER) { if (has_next && wid < 4)
            __builtin_amdgcn_global_load_lds((const unsigned*)S.gptr(nxt, wid * 64 + lane), (LAS unsigned*)(lds + IDX_OFF + ((ui + 1) & 1) * 1024 + wid * 256), 4, 0, 0); }
        asm volatile(".p2align 8" :::);
        for (int t = 0; t < nt; t += 2) {
            const bool last = (t == nt - 2);
            const char* a1 = cA + (t + 1) * kstep;
            const char* a2 = last ? nA : cA + (t + 2) * kstep; const char* b2 = last ? nB : cB + (t + 2) * kstep;
            const char* a3 = a2 + kstep; const char* b3 = b2 + kstep;
            unsigned nv[2][2];
            if constexpr (GATHER) { if (last && has_next) {
                const LAS int* ix = (const LAS int*)(lds + IDX_OFF) + ((ui + 1) & 1) * 256;
#pragma unroll
                for (int _i = 0; _i < 2; ++_i) { int _R, _C; stage_rc(tid * 16 + _i * 8192, _R, _C); nv[0][_i] = (unsigned)(ix[_R] * lda + 2 * _C); nv[1][_i] = (unsigned)(ix[_R + HALF] * lda + 2 * _C); } } }
            if constexpr (SP2) {
            PG8_LDB(B0, 0, 0); PG8_LDB(B1, 0, 1); PG8_SCHED; PG8_LDA(At, 0, 0); PG8_STAGE(PG8_SA(1, 1), a1 + hstepA, voffA[GATHER ? 1 : 0]);
            if constexpr (GATHER) { if (last && has_next) { voffA[0][0] = nv[0][0]; voffA[0][1] = nv[0][1]; voffA[1][0] = nv[1][0]; voffA[1][1] = nv[1][1]; } }
            PG8_WAIT_V(8); PG8_WAIT_L(0); PG8_BAR; PG8_MMA(0, 0, At, B0); PG8_MMA(0, 1, At, B1); PG8_BAR; PG8_SCHED;
            PG8_LDA(At, 0, 1); PG8_STAGE(PG8_SB(0, 0), b2, voffB); PG8_STAGE(PG8_SB(0, 1), b2 + hstepB, voffB); PG8_STAGE(PG8_SA(0, 0), a2, voffA[0]);
            PG8_WAIT_V(8); PG8_WAIT_L(0); PG8_BAR; PG8_MMA(1, 0, At, B0); PG8_MMA(1, 1, At, B1); PG8_BAR; PG8_SCHED;
            PG8_LDB(B0, 1, 0); PG8_LDB(B1, 1, 1); PG8_SCHED; PG8_LDA(At, 1, 0); PG8_STAGE(PG8_SA(0, 1), a2 + hstepA, voffA[GATHER ? 1 : 0]);
            PG8_WAIT_V(8); PG8_WAIT_L(0); PG8_BAR; PG8_MMA(0, 0, At, B0); PG8_MMA(0, 1, At, B1); PG8_BAR; PG8_SCHED;
            PG8_LDA(At, 1, 1); PG8_STAGE(PG8_SB(1, 0), b3, voffB); PG8_STAGE(PG8_SB(1, 1), b3 + hstepB, voffB); PG8_STAGE(PG8_SA(1, 0), a3, voffA[0]);
            PG8_WAIT_V(8); PG8_WAIT_L(0); PG8_BAR; PG8_MMA(1, 0, At, B0); PG8_MMA(1, 1, At, B1); PG8_BAR; PG8_SCHED;
            } else {
            PG8_LDB(B0, 0, 0); PG8_SCHED; PG8_LDA(At, 0, 0); PG8_STAGE(PG8_SA(1, 1), a1 + hstepA, voffA[GATHER ? 1 : 0]);
            if constexpr (GATHER) { if (last && has_next) { voffA[0][0] = nv[0][0]; voffA[0][1] = nv[0][1]; voffA[1][0] = nv[1][0]; voffA[1][1] = nv[1][1]; } }
            PG8_WAIT_L(8); PG8_BAR; PG8_WAIT_L(0); PG8_MMA(0, 0, At, B0); PG8_BAR; PG8_SCHED;
            PG8_LDB(B1, 0, 1); PG8_STAGE(PG8_SB(0, 0), b2, voffB);
            PG8_BAR; PG8_WAIT_L(0); PG8_MMA(0, 1, At, B1); PG8_BAR;
            PG8_LDA(At, 0, 1); PG8_STAGE(PG8_SA(0, 0), a2, voffA[0]);
            PG8_BAR; PG8_WAIT_L(0); PG8_MMA(1, 0, At, B0); PG8_BAR; PG8_SCHED;
            PG8_STAGE(PG8_SB(0, 1), b2 + hstepB, voffB);
            PG8_WAIT_V(6); PG8_BAR; PG8_MMA(1, 1, At, B1); PG8_BAR;
            PG8_LDB(B0, 1, 0); PG8_SCHED; PG8_LDA(At, 1, 0); PG8_STAGE(PG8_SA(0, 1), a2 + hstepA, voffA[GATHER ? 1 : 0]);
            PG8_WAIT_L(8); PG8_BAR; PG8_WAIT_L(0); PG8_MMA(0, 0, At, B0); PG8_BAR; PG8_SCHED;
            PG8_LDB(B1, 1, 1); PG8_STAGE(PG8_SB(1, 0), b3, voffB);
            PG8_BAR; PG8_WAIT_L(0); PG8_MMA(0, 1, At, B1); PG8_BAR;
            PG8_LDA(At, 1, 1); PG8_STAGE(PG8_SA(1, 0), a3, voffA[0]);
            PG8_BAR; PG8_WAIT_L(0); PG8_MMA(1, 0, At, B0); PG8_BAR; PG8_SCHED;
            PG8_STAGE(PG8_SB(1, 1), b3 + hstepB, voffB);
            PG8_WAIT_V(6); PG8_BAR; PG8_MMA(1, 1, At, B1); PG8_BAR;
            }
        }
        if constexpr (FP8) {
            asm volatile("s_nop 15\n\ts_nop 7" ::: "memory");
#pragma unroll
            for (int a = 0; a < 2; ++a)
#pragma unroll
                for (int b = 0; b < 2; ++b) asm volatile("" : "+v"(acc[a][b][0][0]), "+v"(acc[a][b][0][1]), "+v"(acc[a][b][1][0]), "+v"(acc[a][b][1][1]), "+v"(acc[a][b][2][0]), "+v"(acc[a][b][2][1]), "+v"(acc[a][b][3][0]), "+v"(acc[a][b][3][1]));
        }
        if constexpr (ALIGN_EPI) { if (wr == 0) PG8_BAR; }
        E(acc, cur, wr, wc, fr, fq);
#if PROBE_REPEAT == 105
        if constexpr (Epi::PROBE_ID == 5) { asm volatile("s_waitcnt vmcnt(0)" ::: "memory"); E(acc, cur, wr, wc, fr, fq); }
#endif
        if (!has_next) break;
#pragma unroll
        for (int a = 0; a < 2; ++a)
#pragma unroll
            for (int b = 0; b < 2; ++b)
#pragma unroll
                for (int m = 0; m < 4; ++m)
#pragma unroll
                    for (int n = 0; n < 2; ++n) acc[a][b][m][n] = (f32x4){0.f, 0.f, 0.f, 0.f};
        cur = nxt; cA = nA; cB = nB; ++ui;
        if constexpr (FP8) asm volatile("s_nop 3" ::: "memory");
        if constexpr (ALIGN_EPI) { if (wr == 1) PG8_BAR; }
    }
    PG8_WAIT_V(0);
    if constexpr (!ALIGN_EPI) { if (wr == 0) PG8_BAR; }
    PG8_BAR;
#undef PG8_SA
#undef PG8_SB
#undef PG8_STAGE
#undef PG8_LDA
#undef PG8_LDB
#undef PG8_MMA
#undef PG8_WAIT_V
#undef PG8_WAIT_L
#undef PG8_BAR
#undef PG8_SCHED
#undef PG8_GOFF
}
}

struct TItem { const float* src; void* dst; const float* gk; int N, K, k0, n0, drow0, f8; };
__device__ __forceinline__ void titem_load(const TItem& t, f32x4 (&r)[16], int lane) {
    const float* p = t.src + (size_t)(t.k0 + (lane >> 4)) * t.N + t.n0 + 4 * (lane & 15);
#pragma unroll
    for (int i = 0; i < 16; ++i) r[i] = *(const f32x4*)(p + (size_t)(4 * i) * t.N);
}
__device__ __forceinline__ void titem_to_lds(const f32x4 (&r)[16], LAS float* scr, int lane) {
    LAS float* q = scr + (lane >> 4) * 65 + 4 * (lane & 15);
#pragma unroll
    for (int i = 0; i < 16; ++i) { q[(4 * i) * 65 + 0] = r[i].x; q[(4 * i) * 65 + 1] = r[i].y; q[(4 * i) * 65 + 2] = r[i].z; q[(4 * i) * 65 + 3] = r[i].w; }
}
__device__ __forceinline__ void titem_store(const TItem& t, const LAS float* scr, int lane) {
    if (t.f8) { const int c = lane & 3; unsigned char* WT = (unsigned char*)t.dst;
#pragma unroll
        for (int j = 0; j < 4; ++j) { const int n = (lane >> 2) + 16 * j; const LAS float* s = scr + (16 * c) * 65 + n;
            u32x4 o; o.x = pk4_fp8(s[0 * 65] * W8_SCALE, s[1 * 65] * W8_SCALE, s[2 * 65] * W8_SCALE, s[3 * 65] * W8_SCALE); o.y = pk4_fp8(s[4 * 65] * W8_SCALE, s[5 * 65] * W8_SCALE, s[6 * 65] * W8_SCALE, s[7 * 65] * W8_SCALE);
            o.z = pk4_fp8(s[8 * 65] * W8_SCALE, s[9 * 65] * W8_SCALE, s[10 * 65] * W8_SCALE, s[11 * 65] * W8_SCALE); o.w = pk4_fp8(s[12 * 65] * W8_SCALE, s[13 * 65] * W8_SCALE, s[14 * 65] * W8_SCALE, s[15 * 65] * W8_SCALE);
            *(u32x4*)(WT + (size_t)(t.drow0 + n) * t.K + t.k0 + 16 * c) = o; }
    } else { const int c = lane & 7; bf16_t* WT = (bf16_t*)t.dst;
#pragma unroll
        for (int j = 0; j < 8; ++j) { const int n = (lane >> 3) + 8 * j; const LAS float* s = scr + (8 * c) * 65 + n;
            f32x4 ga = (f32x4){1.f, 1.f, 1.f, 1.f}, gb = ga;
            if (t.gk) { ga = *(const f32x4*)(t.gk + t.k0 + 8 * c); gb = *(const f32x4*)(t.gk + t.k0 + 8 * c + 4); }
            u32x4 o; o.x = pk2(s[0 * 65] * ga.x, s[1 * 65] * ga.y); o.y = pk2(s[2 * 65] * ga.z, s[3 * 65] * ga.w); o.z = pk2(s[4 * 65] * gb.x, s[5 * 65] * gb.y); o.w = pk2(s[6 * 65] * gb.z, s[7 * 65] * gb.w);
            *(u32x4*)(WT + (size_t)(t.drow0 + n) * t.K + t.k0 + 8 * c) = o; }
    }
}
constexpr int CI_QKV = 16 * 24, CI_O = 16 * 16, CI_G = 16 * 44, CI_D = 44 * 16, CI_P = 4 * 16, CI_MG = 16 * 56, CI_MD = 56 * 16;
constexpr int CONV_L0 = CI_QKV + CI_O + 2 * CI_G + CI_D + CI_P, CONV_ALL = CONV_L0 + NE * (2 * CI_MG + CI_MD);
struct ConvPtrs { const float *wqkv, *wo, *wg, *wu, *wd, *wp, *mg, *mu, *md; bf16_t *Wqkv, *Wo, *Wgu, *Wd, *Wp; unsigned char *Mgu, *Md; const float *g_attn, *g_ffn; };
__device__ __forceinline__ void conv_decode(const ConvPtrs& P, int item, TItem& t) {
    int it = item, inter = 0, ioff = 0; t.f8 = 0; t.gk = nullptr;
    if (it < CI_QKV) { t.src = P.wqkv; t.dst = P.Wqkv; t.K = D; t.N = QKVW; t.gk = P.g_attn; }
    else if ((it -= CI_QKV) < CI_O) { t.src = P.wo; t.dst = P.Wo; t.K = D; t.N = D; }
    else if ((it -= CI_O) < CI_G) { t.src = P.wg; t.dst = P.Wgu; t.K = D; t.N = DFF; inter = 1; t.gk = P.g_ffn; }
    else if ((it -= CI_G) < CI_G) { t.src = P.wu; t.dst = P.Wgu; t.K = D; t.N = DFF; inter = 1; ioff = 128; t.gk = P.g_ffn; }
    else if ((it -= CI_G) < CI_D) { t.src = P.wd; t.dst = P.Wd; t.K = DFF; t.N = D; }
    else if ((it -= CI_D) < CI_P) { const int g = it / 16; it %= 16; t.src = P.wp + (size_t)g * 256 * 256; t.dst = P.Wp + (size_t)g * 256 * 256; t.K = 256; t.N = 256; }
    else { it -= CI_P; const int per = 2 * CI_MG + CI_MD, e = it / per; it %= per; t.f8 = 1;
        if (it < CI_MG) { t.src = P.mg + (size_t)e * D * DFE; t.dst = P.Mgu + (size_t)e * 2 * DFE * D; t.K = D; t.N = DFE; inter = 1; }
        else if ((it -= CI_MG) < CI_MG) { t.src = P.mu + (size_t)e * D * DFE; t.dst = P.Mgu + (size_t)e * 2 * DFE * D; t.K = D; t.N = DFE; inter = 1; ioff = 128; }
        else { it -= CI_MG; t.src = P.md + (size_t)e * DFE * D; t.dst = P.Md + (size_t)e * D * DFE; t.K = DFE; t.N = D; } }
    const int nnb = t.N / 64, kb = it / nnb, nb = it % nnb; t.k0 = kb * 64; t.n0 = nb * 64;
    t.drow0 = inter ? ((t.n0 >> 7) * 256 + ioff + (t.n0 & 127)) : t.n0;
}
__device__ __forceinline__ void conv_run(LAS unsigned char* lds, const ConvPtrs& P, int lo, int hi, int nblk, int vbid) {
    const int tid0 = opaque_tid(), lane = tid0 & 63, wave = __builtin_amdgcn_readfirstlane(tid0 >> 6), gw = vbid * 8 + wave, ngw = nblk * 8;
    LAS float* scr = (LAS float*)(lds + wave * 16640);
    if (lo + gw < hi) {
        TItem cur, nxt; f32x4 r[16]; int item = lo + gw;
        conv_decode(P, item, cur); titem_load(cur, r, lane);
        for (;;) {
            titem_to_lds(r, scr, lane);
            const int ni = item + ngw; const bool has = ni < hi;
            if (has) { conv_decode(P, ni, nxt); titem_load(nxt, r, lane); }
            LDS_WAIT(); asm volatile("" ::: "memory");
            titem_store(cur, scr, lane);
            LDS_WAIT(); asm volatile("" ::: "memory");
            if (!has) break;
            cur = nxt; item = ni;
        }
    }
}
__device__ __forceinline__ void xcopy_rows2(const float* x0, const float* x1, bool two, bf16_t* o0, bf16_t* o1, float* r0, float* r1, int lane) {
    const f32x4* xa = (const f32x4*)x0 + lane; const f32x4* xb = (const f32x4*)x1 + lane;
    f32x4 va[4], vb[4]; float sa = 0.f, sb = 0.f;
#pragma unroll
    for (int j = 0; j < 4; ++j) { va[j] = xa[64 * j]; vb[j] = xb[64 * j]; }
#pragma unroll
    for (int j = 0; j < 4; ++j) { sa += (va[j].x * va[j].x + va[j].y * va[j].y) + (va[j].z * va[j].z + va[j].w * va[j].w); sb += (vb[j].x * vb[j].x + vb[j].y * vb[j].y) + (vb[j].z * vb[j].z + vb[j].w * vb[j].w); }
    const float ra = 1.0f / sqrtf(wave_sum(sa) * (1.f / D) + RMS_EPS), rb = 1.0f / sqrtf(wave_sum(sb) * (1.f / D) + RMS_EPS);
    u32x2* pa = (u32x2*)o0 + lane; u32x2* pb = (u32x2*)o1 + lane;
#pragma unroll
    for (int j = 0; j < 4; ++j) { u32x2 w; w.x = pk2(va[j].x, va[j].y); w.y = pk2(va[j].z, va[j].w); pa[64 * j] = w; }
    if (lane == 0) *r0 = ra;
    if (two) {
#pragma unroll
        for (int j = 0; j < 4; ++j) { u32x2 w; w.x = pk2(vb[j].x, vb[j].y); w.y = pk2(vb[j].z, vb[j].w); pb[64 * j] = w; }
        if (lane == 0) *r1 = rb; }
}
__device__ __forceinline__ void xcopy_phase(const float* X, bf16_t* O, float* R, int G, int bid) {
    const int tid = opaque_tid(), lane = tid & 63, gw = bid * 8 + __builtin_amdgcn_readfirstlane(tid >> 6), ngw = G * 8;
    for (int m = gw; m < T; m += 2 * ngw) { const int m1 = m + ngw; const bool two = m1 < T; const int mb = two ? m1 : m;
        xcopy_rows2(X + (size_t)m * D, X + (size_t)mb * D, two, O + (size_t)m * D, O + (size_t)mb * D, R + m, R + mb, lane); }
}

__device__ __forceinline__ unsigned ks_off(int key, int c) { return (unsigned)(key * 128 + ((c ^ ((key >> 1) & 7)) << 4)); }
__device__ __forceinline__ unsigned vs_off(int key, int c) { return (unsigned)(key * 128 + ((c ^ (((key >> 1) & 1) << 2)) << 4)); }
template <int OFF> __device__ __forceinline__ void tr_read4(s16x4& a, s16x4& b, s16x4& c, s16x4& d, unsigned b0, unsigned b1) {
    asm volatile("ds_read_b64_tr_b16 %0, %4 offset:%6\n\tds_read_b64_tr_b16 %1, %4 offset:%7\n\tds_read_b64_tr_b16 %2, %5 offset:%6\n\tds_read_b64_tr_b16 %3, %5 offset:%7\n\ts_waitcnt lgkmcnt(0)"
                 : "=&v"(a), "=&v"(b), "=&v"(c), "=&v"(d) : "v"(b0), "v"(b1), "i"(OFF), "i"(OFF + 1024) : "memory");
}
__device__ __forceinline__ void attn_phase(LAS unsigned char* lds, const bf16_t* QKV, bf16_t* O, const float* sinks, int G, int bid) {
    const int tid = opaque_tid(), lane = tid & 63, wid = __builtin_amdgcn_readfirstlane(tid >> 6);
    const int g = wid >> 1, half = wid & 1, ql = lane & 31, h = lane >> 5;
    LAS unsigned char* Ks = lds; LAS unsigned char* Vs = lds + 32768;
    const int i16 = lane & 15, tq = i16 >> 2, tp = i16 & 3, blk = (lane >> 4) & 1;
    for (int u = bid; u < BATCH * 32 * NKV; u += G) {
        const int kvh = u & 3, bn = u >> 2, n = bn & 31, b = bn >> 5;
        const int tok0 = b * SEQ + n * 128;
        __syncthreads();
#pragma unroll
        for (int i = 0; i < 4; ++i) { const int q = tid + 512 * i, row = q >> 3, c = q & 7; const bool valid = (n > 0) || (row >= 128);
            u32x4 kv = (u32x4){0u, 0u, 0u, 0u}, vv = (u32x4){0u, 0u, 0u, 0u};
            if (valid) { const bf16_t* p = QKV + (size_t)(tok0 - 128 + row) * QKVW + 1024 + kvh * 64 + c * 8; kv = *(const u32x4*)p; vv = *(const u32x4*)(p + 256); }
            *(LAS u32x4*)(Ks + ks_off(row, c)) = kv; *(LAS u32x4*)(Vs + vs_off(row, c)) = vv; }
        __syncthreads();
        const int hq = kvh * 4 + g;
        const float slope2 = __builtin_amdgcn_exp2f(-0.5f * (float)(hq + 1)) * LOG2E, sink2 = sinks[hq] * LOG2E;
#pragma unroll 1
        for (int sub = 0; sub < 2; ++sub) {
            const int r0 = half * 64 + sub * 32, c0 = r0 >> 5, r = r0 + ql;
            const bf16_t* qp = QKV + (size_t)(tok0 + r) * QKVW + hq * 64 + 8 * h;
            bf16x8 qf[4];
#pragma unroll
            for (int kk = 0; kk < 4; ++kk) qf[kk] = *(const bf16x8*)(qp + 16 * kk);
            const LAS unsigned char* kb0 = Ks + c0 * 4096 + ks_off(ql, 0 + h); const LAS unsigned char* kb1 = Ks + c0 * 4096 + ks_off(ql, 2 + h);
            const LAS unsigned char* kb2 = Ks + c0 * 4096 + ks_off(ql, 4 + h); const LAS unsigned char* kb3 = Ks + c0 * 4096 + ks_off(ql, 6 + h);
            f32x16 S[5];
#pragma unroll
            for (int ck = 0; ck < 5; ++ck) {
#pragma unroll
                for (int i = 0; i < 16; ++i) S[ck][i] = 0.f;
                S[ck] = __builtin_amdgcn_mfma_f32_32x32x16_bf16(*(const LAS bf16x8*)(kb0 + 4096 * ck), qf[0], S[ck], 0, 0, 0);
                S[ck] = __builtin_amdgcn_mfma_f32_32x32x16_bf16(*(const LAS bf16x8*)(kb1 + 4096 * ck), qf[1], S[ck], 0, 0, 0);
                S[ck] = __builtin_amdgcn_mfma_f32_32x32x16_bf16(*(const LAS bf16x8*)(kb2 + 4096 * ck), qf[2], S[ck], 0, 0, 0);
                S[ck] = __builtin_amdgcn_mfma_f32_32x32x16_bf16(*(const LAS bf16x8*)(kb3 + 4096 * ck), qf[3], S[ck], 0, 0, 0);
            }
            const int bd = 128 + ql - 4 * h, jb = 32 * c0 + 4 * h; const float nb = -slope2 * (float)bd;
            float mxr = -1e30f;
            if (n > 0) {
#pragma unroll
                for (int ck = 0; ck < 5; ++ck)
#pragma unroll
                    for (int i = 0; i < 16; ++i) { const int kc = 32 * ck + (i & 3) + 8 * (i >> 2);
                        float s = __builtin_fmaf(slope2, (float)kc, S[ck][i]);
                        if (ck == 0) s = (kc > bd - 128) ? s : -1e30f;
                        if (ck == 4) s = (kc <= bd) ? s : -1e30f;
                        S[ck][i] = s; mxr = fmaxf(mxr, s); }
            } else {
#pragma unroll
                for (int ck = 0; ck < 5; ++ck)
#pragma unroll
                    for (int i = 0; i < 16; ++i) { const int kc = 32 * ck + (i & 3) + 8 * (i >> 2);
                        const bool valid = (kc <= bd) && (kc > bd - 128) && (jb + kc >= 128);
                        const float s = valid ? __builtin_fmaf(slope2, (float)kc, S[ck][i]) : -1e30f; S[ck][i] = s; mxr = fmaxf(mxr, s); }
            }
            float mt = mxr + nb; mt = fmaxf(mt, __shfl_xor(mt, 32));
            const float mx = fmaxf(mt, sink2), mm = mx - nb;
            float l = 0.f;
            bf16x8 pf[5][2];
#pragma unroll
            for (int ck = 0; ck < 5; ++ck)
#pragma unroll
                for (int s = 0; s < 2; ++s) { float p[8];
#pragma unroll
                    for (int i = 0; i < 8; ++i) { p[i] = __builtin_amdgcn_exp2f(S[ck][8 * s + i] - mm); l += p[i]; }
                    u32x4 pw; pw.x = pk2(p[0], p[1]); pw.y = pk2(p[2], p[3]); pw.z = pk2(p[4], p[5]); pw.w = pk2(p[6], p[7]);
                    pf[ck][s] = __builtin_bit_cast(bf16x8, pw); }
            l += __shfl_xor(l, 32); l += __builtin_amdgcn_exp2f(sink2 - mx);
            const float inv = 1.0f / l;
            f32x16 o0, o1;
#pragma unroll
            for (int i = 0; i < 16; ++i) { o0[i] = 0.f; o1[i] = 0.f; }
            const unsigned vb0 = (unsigned)(size_t)Vs + c0 * 4096 + vs_off(4 * h + tq, 2 * blk + (tp >> 1)) + 8 * (tp & 1);
            const unsigned vb1 = (unsigned)(size_t)Vs + c0 * 4096 + vs_off(4 * h + tq, 4 + 2 * blk + (tp >> 1)) + 8 * (tp & 1);
#define ATT_PV(ck, s) do { s16x4 lo0, hi0, lo1, hi1; tr_read4<4096 * (ck) + 2048 * (s)>(lo0, hi0, lo1, hi1, vb0, vb1); \
                const bf16x8 v0 = __builtin_shufflevector(lo0, hi0, 0, 1, 2, 3, 4, 5, 6, 7), v1 = __builtin_shufflevector(lo1, hi1, 0, 1, 2, 3, 4, 5, 6, 7); \
                o0 = __builtin_amdgcn_mfma_f32_32x32x16_bf16(v0, pf[ck][s], o0, 0, 0, 0); o1 = __builtin_amdgcn_mfma_f32_32x32x16_bf16(v1, pf[ck][s], o1, 0, 0, 0); } while (0)
            ATT_PV(0, 0); ATT_PV(0, 1); ATT_PV(1, 0); ATT_PV(1, 1); ATT_PV(2, 0); ATT_PV(2, 1); ATT_PV(3, 0); ATT_PV(3, 1); ATT_PV(4, 0); ATT_PV(4, 1);
#undef ATT_PV
            bf16_t* op = O + (size_t)(tok0 + r) * D + hq * 64 + 4 * h;
#pragma unroll
            for (int g4 = 0; g4 < 4; ++g4) {
                u32x2 w0; w0.x = pk2(o0[4 * g4 + 0] * inv, o0[4 * g4 + 1] * inv); w0.y = pk2(o0[4 * g4 + 2] * inv, o0[4 * g4 + 3] * inv);
                u32x2 w1; w1.x = pk2(o1[4 * g4 + 0] * inv, o1[4 * g4 + 1] * inv); w1.y = pk2(o1[4 * g4 + 2] * inv, o1[4 * g4 + 3] * inv);
                *(u32x2*)(op + 8 * g4) = w0; *(u32x2*)(op + 32 + 8 * g4) = w1; }
        }
    }
}

template <int W> __device__ __forceinline__ void pool_pass_b(const bf16_t* xc, const LAS float* rs, const f32x4 gn, bf16_t* pout, int base, int rmin, int spos0) {
    f32x4 hist[16];
#pragma unroll
    for (int j = 0; j < 16; ++j) hist[j] = (f32x4){0.f, 0.f, 0.f, 0.f};
    f32x4 S = (f32x4){0.f, 0.f, 0.f, 0.f};
    u32x2 nxt[8];
#pragma unroll
    for (int k = 0; k < 8; ++k) { const int r = base - 16 + k, rc = r < rmin ? rmin : r; nxt[k] = *(const u32x2*)(xc + (long)rc * D); }
#pragma unroll 1
    for (int rb = base - 16; rb < base + 64; rb += 8) {
        f32x4 cur[8];
#pragma unroll
        for (int k = 0; k < 8; ++k) cur[k] = unpack4(nxt[k]);
        if (rb + 8 < base + 64) {
#pragma unroll
            for (int k = 0; k < 8; ++k) { const int r = rb + 8 + k, rc = r < rmin ? rmin : r; nxt[k] = *(const u32x2*)(xc + (long)rc * D); } }
#pragma unroll
        for (int k = 0; k < 8; ++k) { const int r = rb + k, rc = r < rmin ? rmin : r;
            f32x4 hv = cur[k] * rs[rc + 16] * gn;
            if (r < rmin) hv = (f32x4){0.f, 0.f, 0.f, 0.f};
            cur[k] = hv;
            const f32x4 ho = (k - W >= 0) ? cur[(k - W >= 0) ? k - W : 0] : hist[(16 + k - W) & 15];
            S += hv; S -= ho;
            if (r >= base) { const int pos = spos0 + r + 1; const float inv = 1.0f / (float)(pos < W ? pos : W); const f32x4 pv = S * inv - hv;
                u32x2 o; o.x = pk2(pv.x, pv.y); o.y = pk2(pv.z, pv.w); *(u32x2*)(pout + (size_t)r * D) = o; } }
#pragma unroll
        for (int j = 0; j < 8; ++j) { hist[j] = hist[j + 8]; hist[j + 8] = cur[j]; }
    }
}
__device__ __forceinline__ void pool_phase(LAS unsigned char* lds, const bf16_t* X, const float* ssq, const float* gain, bf16_t* P, int G, int bid) {
    const int tid = opaque_tid(), lane = tid & 63, wid = __builtin_amdgcn_readfirstlane(tid >> 6);
    LAS float* rs = (LAS float*)lds;
    const int q = tid & 255, half = tid >> 8, grp = __builtin_amdgcn_readfirstlane(q >> 6), base = 64 * half;
    const f32x4 gn = *(const f32x4*)(gain + 4 * q);
    for (int ch = bid; ch < T / 128; ch += G) {
        const int row0 = ch * 128, spos0 = row0 & (SEQ - 1), halo = spos0 ? 16 : 0;
        __syncthreads();
        if (tid < 128 + halo) { const int i = tid - halo; const f32x4* pp = (const f32x4*)(ssq + (size_t)(row0 + i) * 16);
            const f32x4 a0 = pp[0], a1 = pp[1], a2 = pp[2], a3 = pp[3];
            const float sa = ((a0.x + a0.y) + (a0.z + a0.w)) + ((a1.x + a1.y) + (a1.z + a1.w)) + ((a2.x + a2.y) + (a2.z + a2.w)) + ((a3.x + a3.y) + (a3.z + a3.w));
            rs[i + 16] = 1.0f / sqrtf(sa * (1.f / D) + RMS_EPS); }
        __syncthreads();
        const bf16_t* xc = X + (size_t)row0 * D + 4 * q; bf16_t* pout = P + (size_t)row0 * D + 4 * q;
        if (grp == 0) pool_pass_b<2>(xc, rs, gn, pout, base, -halo, spos0);
        else if (grp == 1) pool_pass_b<4>(xc, rs, gn, pout, base, -halo, spos0);
        else if (grp == 2) pool_pass_b<8>(xc, rs, gn, pout, base, -halo, spos0);
        else pool_pass_b<16>(xc, rs, gn, pout, base, -halo, spos0);
    }
}

__device__ __forceinline__ void router_phase(LAS unsigned char* lds, volatile LAS unsigned* MISC, const bf16_t* X, const float* gain, const float* wr, bf16_t* H,
                                             unsigned* gcnt, int* list, float* gsort, int* tokinfo, int G, int bid) {
    const int tid = opaque_tid(), lane = tid & 63, wid = __builtin_amdgcn_readfirstlane(tid >> 6);
    LAS float* wl = (LAS float*)lds;
    __syncthreads();
    for (int i = tid; i < D * NE / 4; i += 512) ((LAS f32x4*)wl)[i] = ((const f32x4*)wr)[i];
    f32x4 gn[4];
#pragma unroll
    for (int j = 0; j < 4; ++j) gn[j] = ((const f32x4*)gain)[lane + 64 * j];
    volatile LAS unsigned* lcnt = MISC + 32; volatile LAS unsigned* lbase = MISC + 40;
    for (int ch = bid; ch < T / 128; ch += G) {
        if (tid < 8) lcnt[tid] = 0u;
        __syncthreads();
        int me1 = 0, me2 = 0; float mg1 = 0.f, mg2 = 0.f;
        u32x2 vn[4];
        { const u32x2* xr = (const u32x2*)(X + (size_t)(ch * 128 + wid * 16) * D) + lane;
#pragma unroll
          for (int j = 0; j < 4; ++j) vn[j] = xr[64 * j]; }
#pragma unroll 1
        for (int i = 0; i < 16; ++i) {
            const int t = ch * 128 + wid * 16 + i;
            f32x4 v[4]; float s = 0.f;
#pragma unroll
            for (int j = 0; j < 4; ++j) v[j] = unpack4(vn[j]);
            { const u32x2* xr = (const u32x2*)(X + (size_t)(i < 15 ? t + 1 : t) * D) + lane;
#pragma unroll
              for (int j = 0; j < 4; ++j) vn[j] = xr[64 * j]; }
#pragma unroll
            for (int j = 0; j < 4; ++j) s += (v[j].x * v[j].x + v[j].y * v[j].y) + (v[j].z * v[j].z + v[j].w * v[j].w);
            const float rstd = 1.0f / sqrtf(wave_sum(s) * (1.f / D) + RMS_EPS);
            float lg[8];
#pragma unroll
            for (int e = 0; e < 8; ++e) lg[e] = 0.f;
            unsigned* o8 = (unsigned*)((unsigned char*)H + (size_t)t * D) + lane;
#pragma unroll
            for (int j = 0; j < 4; ++j) { const f32x4 y = v[j] * rstd * gn[j]; o8[64 * j] = pk4_fp8(y.x, y.y, y.z, y.w);
#pragma unroll
                for (int q = 0; q < 4; ++q) { const LAS f32x4* wp = (const LAS f32x4*)(wl + (size_t)(4 * lane + 256 * j + q) * 8); const f32x4 wa = wp[0], wb = wp[1]; const float yq = y[q];
                    lg[0] += yq * wa.x; lg[1] += yq * wa.y; lg[2] += yq * wa.z; lg[3] += yq * wa.w; lg[4] += yq * wb.x; lg[5] += yq * wb.y; lg[6] += yq * wb.z; lg[7] += yq * wb.w; } }
#pragma unroll
            for (int e = 0; e < 8; ++e) lg[e] = wave_sum(lg[e]);
            int e1 = 0; float v1 = lg[0];
#pragma unroll
            for (int e = 1; e < 8; ++e) if (lg[e] > v1) { v1 = lg[e]; e1 = e; }
            int e2 = -1; float v2 = -3.0e38f;
#pragma unroll
            for (int e = 0; e < 8; ++e) if (e != e1 && lg[e] > v2) { v2 = lg[e]; e2 = e; }
            const float g2 = 1.0f / (1.0f + __expf(v1 - v2)), g1 = 1.0f - g2;
            if (lane == i) { me1 = e1; me2 = e2; mg1 = g1; mg2 = g2; }
        }
        unsigned lp1 = 0, lp2 = 0;
        if (lane < 16) { lp1 = atomicAdd((unsigned*)(MISC + 32 + me1), 1u); lp2 = atomicAdd((unsigned*)(MISC + 32 + me2), 1u); }
        __syncthreads();
        if (tid < 8) lbase[tid] = __hip_atomic_fetch_add(gcnt + 64 * tid, lcnt[tid], RLX_AGENT);
        __syncthreads();
        if (lane < 16) { const int t = ch * 128 + wid * 16 + lane; const int p1 = (int)(lbase[me1] + lp1), p2 = (int)(lbase[me2] + lp2);
            list[me1 * T + p1] = t; gsort[me1 * T + p1] = mg1; list[me2 * T + p2] = t; gsort[me2 * T + p2] = mg2;
            tokinfo[2 * t] = (me1 << 20) | p1; tokinfo[2 * t + 1] = (me2 << 20) | p2; }
        __syncthreads();
    }
}
__device__ __forceinline__ void moe_tiles(volatile LAS int* tb, unsigned* gcnt) {
    __syncthreads();
    if (threadIdx.x == 0) { int a = 0;
        for (int e = 0; e < 8; ++e) { const int c = (int)__hip_atomic_load(gcnt + 64 * e, RLX_AGENT); tb[e] = a; tb[16 + e] = c; a += (c + 255) >> 8; }
        tb[8] = a; }
    __syncthreads();
}
__device__ __forceinline__ bool combine_row_load(volatile LAS int* tb, const bf16_t* X, const unsigned char* Y, const int* tokinfo, int t, u32x2 (&x)[4], unsigned (&a)[4], unsigned (&b)[4], int lane) {
    const int i0 = tokinfo[2 * t], i1 = tokinfo[2 * t + 1];
    const int s0 = tb[i0 >> 20] * 256 + (i0 & 0xFFFFF), s1 = tb[i1 >> 20] * 256 + (i1 & 0xFFFFF);
    const u32x2* xr = (const u32x2*)(X + (size_t)t * D) + lane; const unsigned* y0 = (const unsigned*)(Y + (size_t)s0 * D) + lane; const unsigned* y1 = (const unsigned*)(Y + (size_t)s1 * D) + lane;
#pragma unroll
    for (int j = 0; j < 4; ++j) { x[j] = xr[64 * j]; a[j] = y0[64 * j]; b[j] = y1[64 * j]; }
    return (s0 >= 256 * 256) || (s1 >= 256 * 256);
}
__device__ __forceinline__ void combine_row_store(float* X, int t, const u32x2 (&xw)[4], const unsigned (&a)[4], const unsigned (&b)[4], const f32x4 (&gn)[4], int lane) {
    float s = 0.f; f32x4 x[4];
#pragma unroll
    for (int j = 0; j < 4; ++j) x[j] = unpack4(xw[j]);
#pragma unroll
    for (int j = 0; j < 4; ++j) {
        const f32x2 al = __builtin_amdgcn_cvt_pk_f32_fp8((int)a[j], false), ah = __builtin_amdgcn_cvt_pk_f32_fp8((int)a[j], true), bl = __builtin_amdgcn_cvt_pk_f32_fp8((int)b[j], false), bh = __builtin_amdgcn_cvt_pk_f32_fp8((int)b[j], true);
        x[j].x += (al.x + bl.x) * pg8::Y8_INV; x[j].y += (al.y + bl.y) * pg8::Y8_INV; x[j].z += (ah.x + bh.x) * pg8::Y8_INV; x[j].w += (ah.y + bh.y) * pg8::Y8_INV;
        s += (x[j].x * x[j].x + x[j].y * x[j].y) + (x[j].z * x[j].z + x[j].w * x[j].w); }
    const float rstd = 1.0f / sqrtf(wave_sum(s) * (1.f / D) + RMS_EPS);
    f32x4* xr = (f32x4*)(X + (size_t)t * D) + lane;
#pragma unroll
    for (int j = 0; j < 4; ++j) xr[64 * j] = x[j] * rstd * gn[j];
}
constexpr int TAIL_SLOT0 = 256 * 256;
__device__ __forceinline__ void combine_main(volatile LAS int* tb, const bf16_t* Xb, float* X, const unsigned char* Y, const int* tokinfo, const float* gain, int nblk, int vbid) {
    const int tid = opaque_tid(), lane = tid & 63, gw = vbid * 8 + __builtin_amdgcn_readfirstlane(tid >> 6), ngw = nblk * 8;
    f32x4 gn[4];
#pragma unroll
    for (int j = 0; j < 4; ++j) gn[j] = ((const f32x4*)gain)[lane + 64 * j];
    for (int t = gw; t < T; t += 2 * ngw) {
        const int t1 = t + ngw; const bool two = t1 < T; const int tb1 = two ? t1 : t;
        u32x2 xa[4], xb[4]; unsigned aa[4], ab[4], ba[4], bb[4];
        const bool taila = combine_row_load(tb, Xb, Y, tokinfo, t, xa, aa, ab, lane);
        const bool tailb = combine_row_load(tb, Xb, Y, tokinfo, tb1, xb, ba, bb, lane);
        if (!taila) combine_row_store(X, t, xa, aa, ab, gn, lane);
        if (two && !tailb) combine_row_store(X, t1, xb, ba, bb, gn, lane);
    }
}
__device__ __forceinline__ void combine_tail(volatile LAS int* tb, const bf16_t* Xb, float* X, const unsigned char* Y, const int* tokinfo, const int* list, const float* gain, int G, int bid) {
    const int tid = opaque_tid(), lane = tid & 63, gw = bid * 8 + __builtin_amdgcn_readfirstlane(tid >> 6), ngw = G * 8;
    f32x4 gn[4];
#pragma unroll
    for (int j = 0; j < 4; ++j) gn[j] = ((const f32x4*)gain)[lane + 64 * j];
    const int send = tb[8] * 256;
    for (int sl = TAIL_SLOT0 + gw; sl < send; sl += ngw) {
        const int tile = sl >> 8; int e = 0;
#pragma unroll
        for (int j = 1; j < 8; ++j) e += (tile >= tb[j]) ? 1 : 0;
        const int pos = sl - tb[e] * 256;
        if (pos >= tb[16 + e]) continue;
        const int t = list[e * T + pos];
        const int i0 = tokinfo[2 * t], i1 = tokinfo[2 * t + 1];
        const int s0 = tb[i0 >> 20] * 256 + (i0 & 0xFFFFF), s1 = tb[i1 >> 20] * 256 + (i1 & 0xFFFFF), other = (s0 == sl) ? s1 : s0;
        if (other >= TAIL_SLOT0 && other > sl) continue;
        u32x2 xa[4]; unsigned aa[4], ab[4];
        (void)combine_row_load(tb, Xb, Y, tokinfo, t, xa, aa, ab, lane);
        combine_row_store(X, t, xa, aa, ab, gn, lane);
    }
}

constexpr int NPHASE = 14;
struct Args { const float* in[18]; float* out; unsigned char* ws; int ph_lo, ph_hi; };
__global__ void __launch_bounds__(512, 2) trunk_fwd(Args args) {
    extern __shared__ __attribute__((aligned(16))) unsigned char lds_raw[];
    LAS unsigned char* lds = (LAS unsigned char*)lds_raw;
    volatile LAS unsigned* MISC = (volatile LAS unsigned*)(lds + MISC_OFF);
    const int tid = threadIdx.x;
    const int G = gridDim.x, bid = blockIdx.x;
    asm volatile("s_setreg_imm32_b32 hwreg(HW_REG_MODE, 23, 1), 1" ::: "memory");
    unsigned char* ws = args.ws;
    unsigned* ctl = (unsigned*)(ws + WS_CTL);
    for (int u = tid; u < (LDS_BYTES - MISC_OFF) / 4; u += 512) MISC[u] = 0u;
    __syncthreads();
    if (tid < 18) { const unsigned long long p = (unsigned long long)args.in[tid]; MISC[64 + 2 * tid] = (unsigned)p; MISC[65 + 2 * tid] = (unsigned)(p >> 32); }
    __syncthreads();
#define INP(k) ((const float*)(((unsigned long long)(unsigned)__builtin_amdgcn_readfirstlane((int)MISC[65 + 2 * (k)]) << 32) | (unsigned long long)(unsigned)__builtin_amdgcn_readfirstlane((int)MISC[64 + 2 * (k)])))
#if MK_PER_PHASE
#define GRID_BAR() do { } while (0)
#else
    XcdBarrier bar = xcd_barrier_post(ctl + CW_BAR, MISC);
#define GRID_BAR() xcd_barrier(bar)
#endif
    const float* x_in = INP(0); float* out = args.out;
    bf16_t* Wqkv = (bf16_t*)(ws + WS_WQKV); bf16_t* Wo = (bf16_t*)(ws + WS_WO); bf16_t* Wgu = (bf16_t*)(ws + WS_WGU); bf16_t* Wd = (bf16_t*)(ws + WS_WD); bf16_t* Wp = (bf16_t*)(ws + WS_WP);
    unsigned char* Mgu = ws + WS_MGU; unsigned char* Md = ws + WS_MD;
    bf16_t* DLT = (bf16_t*)(ws + WS_B + 192 * MiB);
    bf16_t* X2B = (bf16_t*)(ws + WS_B + 256 * MiB);
    bf16_t* X3B = (bf16_t*)(ws + WS_B + 34 * MiB);
    float* RSTD0 = (float*)(ws + WS_B + 182 * MiB);
    float* SSQ = (float*)(ws + WS_B + 180 * MiB);
    bf16_t* HB = (bf16_t*)(ws + WS_HB); bf16_t* QKV = (bf16_t*)(ws + WS_B); bf16_t* ACT = (bf16_t*)(ws + WS_B); unsigned char* Yb = ws + WS_Y; unsigned char* MACT = ws + WS_MACT;
    int* list = (int*)(ws + WS_LIST); float* gsort = (float*)(ws + WS_GSORT); int* tokinfo = (int*)(ws + WS_TOKINFO);
    unsigned* gcnt = ctl + CW_CNT;
    volatile LAS int* tb = (volatile LAS int*)(MISC + 8);
    const int lo = args.ph_lo, hi = args.ph_hi;
#ifndef PHMASK
#define PHMASK 0xFFFFFFFFu
#endif
#define IN(k) ((((PHMASK) >> ((k) < 10 ? (k) : (10 + (((k) - 10) & 1)))) & 1u) && lo <= (k) && (k) < hi)
#define SEAM(k) do { if (IN(k) && IN((k) + 1)) GRID_BAR(); } while (0)

    for (int rep = 0; rep < REPS(0); ++rep) { if (rep) GRID_BAR(); if (IN(0)) {
        { const ConvPtrs CP{INP(2), INP(4), INP(6), INP(7), INP(8), INP(10), INP(14), INP(15), INP(16), Wqkv, Wo, Wgu, Wd, Wp, Mgu, Md, INP(1), INP(5)};
          conv_run(lds, CP, 0, CONV_L0, G, bid); }
        xcopy_phase(x_in, DLT, RSTD0, G, bid);
    }
    }
    SEAM(0);
    for (int rep = 0; rep < REPS(1); ++rep) { if (rep) GRID_BAR(); if (IN(1)) {
        pg8::DenseOrder S{(const char*)DLT, (const char*)Wqkv, 2 * D, 2 * D, T / 256, QKVW / 256, G, bid, 0}; pg8::EpiQKV E{QKV, RSTD0};
        pg8::gemm_phase<pg8::EpiQKV, pg8::DenseOrder, false, true, true, false>(lds, S, E, 2 * D, 2 * D, 2 * D);
    }
    }
    SEAM(1);
    for (int rep = 0; rep < REPS(2); ++rep) { if (rep) GRID_BAR(); if (IN(2)) {
        const int nconv = (G * 3) / 8;
        constexpr int CONV_X = CONV_L0 + (int)((long)(CONV_ALL - CONV_L0) * 27 / 32);
        const ConvPtrs CP{INP(2), INP(4), INP(6), INP(7), INP(8), INP(10), INP(14), INP(15), INP(16), Wqkv, Wo, Wgu, Wd, Wp, Mgu, Md, INP(1), INP(5)};
        if (bid < nconv) conv_run(lds, CP, CONV_L0, CONV_X, nconv, bid);
        else { attn_phase(lds, QKV, HB, INP(3), G - nconv, bid - nconv); __syncthreads(); conv_run(lds, CP, CONV_X, CONV_ALL, G - nconv, bid - nconv); } }
    }
    SEAM(2);
    for (int rep = 0; rep < REPS(3); ++rep) { if (rep) GRID_BAR(); if (IN(3)) {
        pg8::DenseOrder S{(const char*)HB, (const char*)Wo, 2 * D, 2 * D, T / 256, D / 256, G, bid, 0}; pg8::EpiResF32 E{DLT, DLT, nullptr, SSQ};
        pg8::gemm_phase<pg8::EpiResF32, pg8::DenseOrder, false, true, true, false>(lds, S, E, 2 * D, 2 * D, 2 * D);
    }
    }
    SEAM(3);
    for (int rep = 0; rep < REPS(5); ++rep) { if (rep) GRID_BAR(); if (IN(5)) {
        pg8::DenseOrder S{(const char*)DLT, (const char*)Wgu, 2 * D, 2 * D, T / 256, 2 * DFF / 256, G, bid, 0}; pg8::EpiSwiGLU<false> E{(unsigned char*)ACT, 2 * DFF, 0, SSQ, nullptr};
        { constexpr int RT_OFF = pg8::IDX_OFF + 2048, RT_MAX = (MISC_OFF - RT_OFF) / 1024;
          LAS float* rt = (LAS float*)(lds + RT_OFF); pg8::Unit u; int nu = 0;
          while (S.next(nu, u)) ++nu;
          if (nu <= RT_MAX) {
              if (tid < 256) for (int i = 0; i < nu; ++i) { (void)S.next(i, u); const f32x4* pp = (const f32x4*)(SSQ + (size_t)(u.pm * 256 + tid) * 16); const f32x4 a0 = pp[0], a1 = pp[1], a2 = pp[2], a3 = pp[3];
                  const float sa = ((a0.x + a0.y) + (a0.z + a0.w)) + ((a1.x + a1.y) + (a1.z + a1.w)) + ((a2.x + a2.y) + (a2.z + a2.w)) + ((a3.x + a3.y) + (a3.z + a3.w));
                  rt[i * 256 + tid] = 1.0f / sqrtf(sa * (1.f / D) + RMS_EPS); }
              E.rtab = rt; }
          __syncthreads(); }
        pg8::gemm_phase<pg8::EpiSwiGLU<false>, pg8::DenseOrder, false, true, true, false>(lds, S, E, 2 * D, 2 * D, 2 * D);
    }
    }
    SEAM(5);
    for (int rep = 0; rep < REPS(6); ++rep) { if (rep) GRID_BAR();
    if (IN(6)) {
        pg8::DenseOrder S{(const char*)ACT, (const char*)Wd, 2 * DFF, 2 * DFF, T / 256, D / 256, G, bid, 0}; pg8::EpiResF32 E{DLT, X2B, nullptr, SSQ};
        pg8::gemm_phase<pg8::EpiResF32, pg8::DenseOrder, false, true, true, false>(lds, S, E, 2 * DFF, 2 * DFF, 2 * DFF);
    }
    }
    SEAM(6);
    for (int rep = 0; rep < REPS(7); ++rep) { if (rep) GRID_BAR(); if (IN(7)) pool_phase(lds, X2B, SSQ, INP(9), HB, G, bid);
    }
    SEAM(7);
    if (IN(8)) {
        pg8::DenseOrder S{(const char*)HB, (const char*)Wp, 2 * D, 512, T / 256, 4, G, bid, 1}; pg8::EpiResF32 E{X2B, X3B, INP(11), nullptr};
        pg8::gemm_phase<pg8::EpiResF32, pg8::DenseOrder, false, true, true, false>(lds, S, E, 512, 2 * D, 512);
    }
    SEAM(8);
    if (IN(9)) router_phase(lds, MISC, X3B, INP(12), INP(13), HB, gcnt, list, gsort, tokinfo, G, bid);
    SEAM(9);
    if (hi > 10) moe_tiles(tb, gcnt);
    {
        const int Gt = tb[8], Gm = Gt < 256 ? Gt : 256, ntail = Gt - Gm;
        for (int rep = 0; rep < REPS(10); ++rep) { if (rep) GRID_BAR();
        if (IN(10) && Gt > 0) {
            pg8::MoeOrder S{(const char*)HB, (const char*)Mgu, D, D, Gt, 2 * DFE / 256, G, bid, 0, 0, (size_t)2 * DFE * D, tb, list, 1}; pg8::EpiSwiGLU<true> E{MACT, DFE, 0};
            pg8::gemm_phase<pg8::EpiSwiGLU<true>, pg8::MoeOrder, true, true, true, true>(lds, S, E, D, D, D);
        }
        }
        SEAM(10);
        for (int rep = 0; rep < REPS(11); ++rep) { if (rep) GRID_BAR();
        if (IN(11) && Gm > 0) {
            pg8::MoeOrder S{(const char*)MACT, (const char*)Md, DFE, DFE, Gm, D / 256, G, bid, 0, 0, (size_t)D * DFE, tb, list, 0}; pg8::EpiMoeDown E{Yb, gsort, tb};
            pg8::gemm_phase<pg8::EpiMoeDown, pg8::MoeOrder, false, true, true, true>(lds, S, E, DFE, DFE, DFE);
        }
        }
        SEAM(11);
        if (IN(12)) {
            const int nbusy = 4 * ntail;
            if (ntail > 0) {
                pg8::MoeOrder S{(const char*)MACT, (const char*)Md, DFE, DFE, ntail, D / 256, G, bid, 0, 256, (size_t)D * DFE, tb, list, 0}; pg8::EpiMoeDown E{Yb, gsort, tb};
                pg8::gemm_phase<pg8::EpiMoeDown, pg8::MoeOrder, false, true, true, true>(lds, S, E, DFE, DFE, DFE);
            }
            if (bid >= nbusy && G > nbusy) combine_main(tb, X3B, out, Yb, tokinfo, INP(17), G - nbusy, bid - nbusy);
            else if (G <= nbusy) combine_main(tb, X3B, out, Yb, tokinfo, INP(17), G, bid);
        }
        SEAM(12);
        if (IN(13)) combine_tail(tb, X3B, out, Yb, tokinfo, list, INP(17), G, bid);
    }
#undef IN
#undef SEAM
#undef INP
}

extern "C" void kernel_launch(void* const* d_in, const int* in_sizes, int n_in, void* d_out, int out_size, void* d_ws, size_t ws_size, hipStream_t stream) {
    static int grid = 0;
    if (grid == 0) {
        if (n_in != 18 || in_sizes[0] != T * D || out_size != T * D || ws_size < WS_END) { fprintf(stderr, "kernel_launch: unexpected shapes / workspace (%d inputs, ws %zu < %zu)\n", n_in, ws_size, (size_t)WS_END); grid = -1; return; }
        int dev = 0, cus = 0, per_cu = 0;
        if (hipGetDevice(&dev) != hipSuccess || hipDeviceGetAttribute(&cus, hipDeviceAttributeMultiprocessorCount, dev) != hipSuccess) { grid = -1; return; }
        if (hipFuncSetAttribute((const void*)trunk_fwd, hipFuncAttributeMaxDynamicSharedMemorySize, LDS_BYTES) != hipSuccess) { fprintf(stderr, "kernel_launch: hipFuncSetAttribute failed\n"); grid = -1; return; }
        if (hipOccupancyMaxActiveBlocksPerMultiprocessor(&per_cu, (const void*)trunk_fwd, 512, LDS_BYTES) != hipSuccess || per_cu < 1) fprintf(stderr, "kernel_launch: occupancy query reports %d\n", per_cu);
        (void)hipGetLastError();
        grid = cus;
    }
    if (grid < 0) return;
    if (hipMemsetAsync((char*)d_ws + WS_CTL, 0, CTL_ZERO_BYTES, stream) != hipSuccess) return;
    Args a{};
    for (int i = 0; i < 18; ++i) a.in[i] = (const float*)d_in[i];
    a.out = (float*)d_out; a.ws = (unsigned char*)d_ws;
#if MK_PER_PHASE
    for (int ph = 0; ph < NPHASE; ++ph) { a.ph_lo = ph; a.ph_hi = ph + 1; hipLaunchKernelGGL(trunk_fwd, dim3(grid), dim3(512), LDS_BYTES, stream, a); }
#else
    a.ph_lo = 0; a.ph_hi = NPHASE;
    hipLaunchKernelGGL(trunk_fwd, dim3(grid), dim3(512), LDS_BYTES, stream, a);
#endif
}
```

```cpp
#include <hip/hip_runtime.h>
#include <cstdio>
#include <cstdint>

#ifndef MK_PER_PHASE
#define MK_PER_PHASE 0
#endif

#ifndef PROBE_REPEAT
#define PROBE_REPEAT -1
#endif
#ifndef DENSE_WGM
#define DENSE_WGM 4
#endif
#ifndef MOE_WGM
#define MOE_WGM 4
#endif
#ifndef PROBE_N
#define PROBE_N 2
#endif
#define REPS(k) ((PROBE_REPEAT) == (k) ? (PROBE_N) : 1)
#define LAS __attribute__((address_space(3)))
#define GAS __attribute__((address_space(1)))
typedef unsigned short bf16_t;
typedef short bf16x8 __attribute__((ext_vector_type(8)));
typedef short s16x4 __attribute__((ext_vector_type(4)));
typedef float f32x4 __attribute__((ext_vector_type(4)));
typedef float f32x2 __attribute__((ext_vector_type(2)));
typedef float f32x16 __attribute__((ext_vector_type(16)));
typedef unsigned u32x4 __attribute__((ext_vector_type(4)));
typedef unsigned u32x2 __attribute__((ext_vector_type(2)));
typedef __bf16 bf16v2 __attribute__((ext_vector_type(2)));
typedef int i32x8 __attribute__((ext_vector_type(8)));
typedef int i32x4 __attribute__((ext_vector_type(4)));

constexpr int BATCH = 8, SEQ = 4096, T = BATCH * SEQ, D = 1024, QKVW = 1536, DFF = 2816, NE = 8, DFE = 3584, NHEAD = 16, NKV = 4, HD = 64;
constexpr float RMS_EPS = 1e-5f, LOG2E = 1.4426950408889634f;
constexpr float QSCALE = 0.125f * LOG2E;
constexpr int NPASS = 1, TPMAX = 264, GMAX = 264;

constexpr size_t MiB = 1u << 20;
constexpr size_t WS_CTL = 0, CTL_ZERO_BYTES = 128 * 1024;
constexpr size_t WS_LIST = 1 * MiB;
constexpr size_t WS_GSORT = 2 * MiB;
constexpr size_t WS_TOKINFO = 3 * MiB;
constexpr size_t WS_WQKV = 4 * MiB;
constexpr size_t WS_WO = 7 * MiB;
constexpr size_t WS_WGU = 9 * MiB;
constexpr size_t WS_WD = 20 * MiB;
constexpr size_t WS_WP = 26 * MiB;
constexpr size_t WS_MGU = 27 * MiB;
constexpr size_t WS_MD = 83 * MiB;
constexpr size_t WS_HB = 111 * MiB;
constexpr size_t WS_B = 175 * MiB;
constexpr size_t WS_Y = WS_HB + 32 * MiB, WS_MACT = WS_Y + 132 * MiB;
constexpr size_t WS_END = WS_MACT + (size_t)TPMAX * 256 * DFE;
static_assert(WS_END <= 512 * MiB, "workspace");
static_assert((size_t)GMAX * 256 * D * 2 <= 132 * MiB, "y");
static_assert(WS_MGU + (size_t)NE * 2 * DFE * D <= WS_MD && WS_MD + (size_t)NE * D * DFE <= WS_HB && WS_HB + (size_t)T * D * 2 <= WS_B, "map");
static_assert(WS_B + (size_t)T * DFF * 2 <= 512 * MiB, "act");
constexpr int CW_TMO = 0;
constexpr int CW_BAR = 4096;
constexpr int CW_CNT = 16384;

constexpr int RING_BYTES = 131072;
constexpr int LDS_BYTES = 147456;
constexpr int MISC_OFF = 146432;

#define RLX_AGENT __ATOMIC_RELAXED, __HIP_MEMORY_SCOPE_AGENT
#define LDS_WAIT() asm volatile("s_waitcnt lgkmcnt(0)" ::: "memory")
#define VM_WAIT() asm volatile("s_waitcnt vmcnt(0)" ::: "memory")

__device__ __forceinline__ unsigned pk2(float lo, float hi) { bf16v2 v = {(__bf16)lo, (__bf16)hi}; return __builtin_bit_cast(unsigned, v); }
__device__ __forceinline__ f32x4 unpack4(const u32x2 w) { return (f32x4){__uint_as_float(w.x << 16), __uint_as_float(w.x & 0xFFFF0000u), __uint_as_float(w.y << 16), __uint_as_float(w.y & 0xFFFF0000u)}; }
constexpr float W8_SCALE = 64.0f, W8_INV = 1.0f / 64.0f;
__device__ __forceinline__ unsigned pk4_fp8(float a, float b, float c, float d) {
    unsigned w = 0u; w = (unsigned)__builtin_amdgcn_cvt_pk_fp8_f32(a, b, (int)w, false); w = (unsigned)__builtin_amdgcn_cvt_pk_fp8_f32(c, d, (int)w, true); return w; }
__device__ __forceinline__ int opaque_tid() { int t = threadIdx.x; asm volatile("" : "+v"(t)); return t; }
template <int CTRL> __device__ __forceinline__ float dpp_mov(float v) { return __builtin_bit_cast(float, __builtin_amdgcn_update_dpp(0, __builtin_bit_cast(int, v), CTRL, 0xF, 0xF, true)); }
__device__ __forceinline__ float wave_sum(float v) {
    v += dpp_mov<0xB1>(v);
    v += dpp_mov<0x4E>(v);
    v += dpp_mov<0x141>(v);
    v += dpp_mov<0x140>(v);
    v += __shfl_xor(v, 16); v += __shfl_xor(v, 32);
    return v;
}

#define XB_TMO      128
#define XB_XCNT(j)  (256  + 64 * (j))
#define XB_XSUB(j)  (1280 + 64 * (j))
#define XB_XGEN(j)  (2304 + 64 * (j))
#define XB_TOP      3328
#define XB_TOPGEN   3392
#define XCD_BAR_WORDS 3456
#define XB_SPIN_CAP (1u << 18)
__device__ __forceinline__ unsigned xb_ld(unsigned* p)              { return __hip_atomic_load(p, __ATOMIC_RELAXED, __HIP_MEMORY_SCOPE_AGENT); }
__device__ __forceinline__ unsigned xb_add(unsigned* p, unsigned v) { return __hip_atomic_fetch_add(p, v, __ATOMIC_RELAXED, __HIP_MEMORY_SCOPE_AGENT); }
__device__ __forceinline__ unsigned xb_xcc_id() { return (unsigned)__builtin_amdgcn_s_getreg((3 << 11) | 20) & 0xFu; }
#define XB_SPIN(cond, bar) do { unsigned _sp = 0; while (cond) { __builtin_amdgcn_s_sleep(1); \
    if ((++_sp & 255u) == 0u) { if (xb_ld(&(bar)[XB_TMO])) break; if (_sp > XB_SPIN_CAP) { atomicAdd(&(bar)[XB_TMO], 1u); break; } } } } while (0)
struct XcdBarrier { unsigned* bar; unsigned x; volatile LAS unsigned* st; };
__device__ __forceinline__ XcdBarrier xcd_barrier_post(unsigned* bar, volatile LAS unsigned* st) {
    XcdBarrier b; b.bar = bar; b.x = xb_xcc_id(); b.st = st;
    if (threadIdx.x == 0) (void)xb_add(&bar[XB_XCNT(b.x)], 1u);
    return b;
}
__device__ __forceinline__ void xcd_barrier_complete(unsigned* bar, unsigned x, unsigned& nloc, unsigned& nx) {
    const unsigned G = gridDim.x * gridDim.y * gridDim.z;
    unsigned sum, cnt, mine, sp = 0u;
    for (;;) {
        sum = 0u; cnt = 0u; mine = 0u;
#pragma unroll
        for (unsigned j = 0; j < 16; ++j) { const unsigned c = xb_ld(&bar[XB_XCNT(j)]); sum += c; cnt += (c > 0u) ? 1u : 0u; mine = (j == x) ? c : mine; }
        if (sum == G) break;
        __builtin_amdgcn_s_sleep(1);
        if ((++sp & 255u) == 0u) { if (xb_ld(&bar[XB_TMO])) break; if (sp > XB_SPIN_CAP) { atomicAdd(&bar[XB_TMO], 1u); break; } }
    }
    nloc = mine > 0u ? mine : 1u; nx = cnt > 0u ? cnt : 1u;
}
__device__ __forceinline__ void xcd_barrier(const XcdBarrier& b) {
    asm volatile("s_waitcnt vmcnt(0)" ::: "memory");
    __syncthreads();
    if (threadIdx.x == 0) {
        unsigned* bar = b.bar;
        __builtin_amdgcn_s_waitcnt(0);
        unsigned nloc = b.st[0], nx = b.st[1];
        if (nloc == 0u) { xcd_barrier_complete(bar, b.x, nloc, nx); b.st[0] = nloc; b.st[1] = nx; }
        const unsigned old = xb_add(&bar[XB_XSUB(b.x)], 1u);
        const unsigned gen = old / nloc;
        if (old + 1u == (gen + 1u) * nloc) {
            __builtin_amdgcn_fence(__ATOMIC_RELEASE, "agent");
            asm volatile("s_waitcnt vmcnt(0)" ::: "memory");
            const unsigned og = xb_add(&bar[XB_TOP], 1u);
            const unsigned tg = og / nx;
            if (og + 1u == (tg + 1u) * nx) xb_add(&bar[XB_TOPGEN], 1u);
            else XB_SPIN(xb_ld(&bar[XB_TOPGEN]) == tg, bar);
            __builtin_amdgcn_fence(__ATOMIC_ACQUIRE, "agent");
            xb_add(&bar[XB_XGEN(b.x)], 1u);
            asm volatile("s_waitcnt vmcnt(0)" ::: "memory");
        } else {
            XB_SPIN(xb_ld(&bar[XB_XGEN(b.x)]) == gen, bar);
            __builtin_amdgcn_fence(__ATOMIC_ACQUIRE, "agent");
            asm volatile("s_waitcnt vmcnt(0)" ::: "memory");
        }
    }
    __syncthreads();
}

namespace pg8 {
constexpr int BM = 256, BK = 64, HALF = 128, HTB = HALF * BK * 2, NXCD = 8, WGM = 8;
constexpr int IDX_OFF = 131072;
__device__ __forceinline__ int lds_byte(int r, int c) { const int st = (r >> 4) * 2 + (c >> 5), rr = r & 15, cc = c & 31, ob = rr * 64 + cc * 2; return st * 1024 + (ob ^ (((ob >> 9) & 1) << 5)); }
__device__ __forceinline__ void stage_rc(int b, int& R, int& C) { const int st = b / 1024, sb = b % 1024, swz = sb ^ (((sb >> 9) & 1) << 5); R = (st >> 1) * 16 + swz / 64; C = (st & 1) * 32 + (swz % 64) / 2; }
__device__ __forceinline__ int perm32(int rho) { const int n = rho >> 4, i = rho & 15; return 8 * (i >> 2) + 4 * n + (i & 3); }

struct Unit { int pm, pn, e; };

__device__ __forceinline__ bool tile_of(int i, int G, int c, int nM, int nN, int& pm, int& pn, const int wgm = WGM) {
    const int nwg = nM * nN; const int L = i * G + c; if (L >= nwg) return false;
    int wgid = L; { const int q = nwg / NXCD, r = nwg % NXCD, xcd = wgid % NXCD, off = wgid / NXCD; wgid = (xcd < r ? xcd * (q + 1) : r * (q + 1) + (xcd - r) * q) + off; }
    const int nig = wgm * nN, gid = wgid / nig, fm = gid * wgm, gsz = (nM - fm) < wgm ? (nM - fm) : wgm;
    pm = fm + ((wgid % nig) % gsz); pn = (wgid % nig) / gsz; return true;
}
struct DenseOrder {
    const char* A; const char* Bt; int lda, ldb, nM, nN, G, c; int grouped;
    __device__ __forceinline__ bool next(int i, Unit& u) const { u.e = i; return tile_of(i, G, c, nM, nN, u.pm, u.pn, DENSE_WGM); }
    __device__ __forceinline__ const char* a_base(const Unit& u) const { return A + (size_t)u.pm * 256 * lda + (grouped ? u.pn * 512 : 0); }
    __device__ __forceinline__ const char* b_base(const Unit& u) const { return Bt + (size_t)u.pn * 256 * ldb; }
    __device__ __forceinline__ int grow(const Unit&, int) const { return 0; }
    __device__ __forceinline__ const int* gptr(const Unit&, int) const { return nullptr; }
};
struct MoeOrder {
    const char* A; const char* Bt; int lda, ldb, nM, nN, G, c, t0, toff; size_t bstride;
    const volatile LAS int* tb; const int* list; int gather;
    __device__ __forceinline__ bool next(int i, Unit& u) const {
        if (!tile_of(i, G, c, nM, nN, u.pm, u.pn, MOE_WGM)) return false;
        u.pm += toff; int e = 0;
#pragma unroll
        for (int j = 1; j < 8; ++j) e += (u.pm >= tb[j]) ? 1 : 0;
        u.e = __builtin_amdgcn_readfirstlane(e); return true;
    }
    __device__ __forceinline__ const char* a_base(const Unit& u) const { return gather ? A : A + (size_t)(u.pm - t0) * 256 * lda; }
    __device__ __forceinline__ const char* b_base(const Unit& u) const { return Bt + (size_t)u.e * bstride + (size_t)u.pn * 256 * ldb; }
    __device__ __forceinline__ int grow(const Unit& u, int r) const {
        const int tbe = __builtin_amdgcn_readfirstlane(tb[u.e]), n = __builtin_amdgcn_readfirstlane(tb[16 + u.e]);
        int p = (u.pm - tbe) * 256 + r; p = p < n ? p : n - 1;
        return list[u.e * T + p];
    }
    __device__ __forceinline__ const int* gptr(const Unit& u, int r) const {
        const int tbe = __builtin_amdgcn_readfirstlane(tb[u.e]), n = __builtin_amdgcn_readfirstlane(tb[16 + u.e]);
        int p = (u.pm - tbe) * 256 + r; p = p < n ? p : n - 1;
        return list + u.e * T + p;
    }
};

struct EpiQKV {
    static constexpr bool PERM = true; static constexpr int PROBE_ID = 1;
    bf16_t* O; const float* rstd;
    __device__ __forceinline__ void operator()(const f32x4 (&acc)[2][2][4][2], const Unit& u, int wr, int wc, int fr, int fq) const {
        const int row0 = u.pm * BM + wr * 64 + fr, col0 = u.pn * BM + wc * 32 + 8 * fq; const float sc0 = (u.pn < 4) ? QSCALE : 1.0f;
        float rs[2][4];
#pragma unroll
        for (int ai = 0; ai < 2; ++ai)
#pragma unroll
            for (int m = 0; m < 4; ++m) rs[ai][m] = rstd[row0 + ai * HALF + m * 16];
#pragma unroll
        for (int ai = 0; ai < 2; ++ai)
#pragma unroll
            for (int m = 0; m < 4; ++m) { bf16_t* rowp = O + (size_t)(row0 + ai * HALF + m * 16) * QKVW + col0; const float sc = sc0 * rs[ai][m];
#pragma unroll
                for (int bj = 0; bj < 2; ++bj) { const f32x4 v0 = acc[ai][bj][m][0] * sc, v1 = acc[ai][bj][m][1] * sc;
                    u32x4 w; w.x = pk2(v0[0], v0[1]); w.y = pk2(v0[2], v0[3]); w.z = pk2(v1[0], v1[1]); w.w = pk2(v1[2], v1[3]);
                    *(u32x4*)(rowp + bj * HALF) = w; } }
    }
};
struct EpiResF32 {
    static constexpr bool PERM = true; static constexpr int PROBE_ID = 3;
    const bf16_t* res; bf16_t* out; const float* scale; float* ssq;
    __device__ __forceinline__ void operator()(const f32x4 (&acc)[2][2][4][2], const Unit& u, int wr, int wc, int fr, int fq) const {
        const int row0 = u.pm * BM + wr * 64 + fr, col0 = u.pn * BM + wc * 32 + 8 * fq;
        float sq[2][4];
#pragma unroll
        for (int ai = 0; ai < 2; ++ai)
#pragma unroll
            for (int m = 0; m < 4; ++m) sq[ai][m] = 0.f;
#pragma unroll
        for (int bj = 0; bj < 2; ++bj) {
            f32x4 s0 = (f32x4){1.f, 1.f, 1.f, 1.f}, s1 = s0;
            if (scale) { s0 = *(const f32x4*)(scale + col0 + bj * HALF); s1 = *(const f32x4*)(scale + col0 + bj * HALF + 4); }
#pragma unroll
            for (int ai = 0; ai < 2; ++ai) {
#pragma unroll
                for (int m = 0; m < 4; ++m) { const size_t off = (size_t)(row0 + ai * HALF + m * 16) * D + col0 + bj * HALF; const u32x4 rw = *(const u32x4*)(res + off);
                    const f32x4 o0 = unpack4((u32x2){rw.x, rw.y}) + acc[ai][bj][m][0] * s0, o1 = unpack4((u32x2){rw.z, rw.w}) + acc[ai][bj][m][1] * s1;
                    u32x4 w; w.x = pk2(o0.x, o0.y); w.y = pk2(o0.z, o0.w); w.z = pk2(o1.x, o1.y); w.w = pk2(o1.z, o1.w);
                    *(u32x4*)(out + off) = w;
                    sq[ai][m] += (o0.x * o0.x + o0.y * o0.y) + (o0.z * o0.z + o0.w * o0.w) + (o1.x * o1.x + o1.y * o1.y) + (o1.z * o1.z + o1.w * o1.w); }
                asm volatile("" ::: "memory"); } }
        if (ssq) {
#pragma unroll
            for (int ai = 0; ai < 2; ++ai)
#pragma unroll
                for (int m = 0; m < 4; ++m) { float v = sq[ai][m]; v += __shfl_xor(v, 16); v += __shfl_xor(v, 32);
                    if (fq == 0) ssq[(size_t)(row0 + ai * HALF + m * 16) * 16 + 4 * u.pn + wc] = v; } }
    }
};
__device__ __forceinline__ float silu_mul(float g, float u) { return g * u * __builtin_amdgcn_rcpf(1.0f + __builtin_amdgcn_exp2f(-g * LOG2E)); }
__device__ __forceinline__ f32x2 silu_mul_pk(f32x2 g, f32x2 u) {
    const f32x2 a2 = g * (-LOG2E); f32x2 t; t.x = __builtin_amdgcn_exp2f(a2.x); t.y = __builtin_amdgcn_exp2f(a2.y);
    const f32x2 d = t + 1.0f; f32x2 r; r.x = __builtin_amdgcn_rcpf(d.x); r.y = __builtin_amdgcn_rcpf(d.y);
    return (g * u) * r;
}
__device__ __forceinline__ f32x2 silu_mul64_pk(f32x2 a, f32x2 b) {
    const f32x2 a2 = a * (-LOG2E * W8_INV); f32x2 t; t.x = __builtin_amdgcn_exp2f(a2.x); t.y = __builtin_amdgcn_exp2f(a2.y);
    const f32x2 d = t * 4096.0f + 4096.0f; f32x2 r; r.x = __builtin_amdgcn_rcpf(d.x); r.y = __builtin_amdgcn_rcpf(d.y);
    return (a * b) * r;
}
__device__ __forceinline__ float silu_mul64(float a, float b) { return a * b * __builtin_amdgcn_rcpf(__builtin_fmaf(__builtin_amdgcn_exp2f(a * (-LOG2E * W8_INV)), 4096.0f, 4096.0f)); }
template <bool F8> struct EpiSwiGLU {
    static constexpr bool PERM = true; static constexpr int PROBE_ID = 5;
    unsigned char* O; int ldc, tile0; const float* ssq = nullptr; const LAS float* rtab = nullptr;
    __device__ __forceinline__ void operator()(const f32x4 (&acc)[2][2][4][2], const Unit& u, int wr, int wc, int fr, int fq) const {
        const int row0 = (u.pm - tile0) * BM + wr * 64 + fr, col0 = u.pn * HALF + wc * 32 + 8 * fq;
#pragma unroll
        for (int ai = 0; ai < 2; ++ai)
#pragma unroll
            for (int m = 0; m < 4; ++m) { unsigned char* rowp = O + (size_t)(row0 + ai * HALF + m * 16) * ldc + col0 * (F8 ? 1 : 2);
                f32x4 g0 = acc[ai][0][m][0], g1 = acc[ai][0][m][1], u0 = acc[ai][1][m][0], u1 = acc[ai][1][m][1];
                if constexpr (F8) {
                    const f32x2 p0 = silu_mul64_pk((f32x2){g0[0], g0[1]}, (f32x2){u0[0], u0[1]}), p1 = silu_mul64_pk((f32x2){g0[2], g0[3]}, (f32x2){u0[2], u0[3]});
                    const f32x2 p2 = silu_mul64_pk((f32x2){g1[0], g1[1]}, (f32x2){u1[0], u1[1]}), p3 = silu_mul64_pk((f32x2){g1[2], g1[3]}, (f32x2){u1[2], u1[3]});
                    u32x2 w; w.x = pk4_fp8(p0.x, p0.y, p1.x, p1.y); w.y = pk4_fp8(p2.x, p2.y, p3.x, p3.y);
                    __builtin_nontemporal_store(w, (u32x2*)rowp); }
                else {
                    if (rtab) { const float r = rtab[u.e * 256 + wr * 64 + fr + ai * HALF + m * 16]; g0 *= r; g1 *= r; u0 *= r; u1 *= r; }
                    else if (ssq) { const f32x4* pp = (const f32x4*)(ssq + (size_t)(row0 + ai * HALF + m * 16) * 16); const f32x4 a0 = pp[0], a1 = pp[1], a2 = pp[2], a3 = pp[3];
                        const float sa = ((a0.x + a0.y) + (a0.z + a0.w)) + ((a1.x + a1.y) + (a1.z + a1.w)) + ((a2.x + a2.y) + (a2.z + a2.w)) + ((a3.x + a3.y) + (a3.z + a3.w));
                        const float r = 1.0f / sqrtf(sa * (1.f / D) + RMS_EPS); g0 *= r; g1 *= r; u0 *= r; u1 *= r; }
                    const f32x2 p0 = silu_mul_pk((f32x2){g0[0], g0[1]}, (f32x2){u0[0], u0[1]}), p1 = silu_mul_pk((f32x2){g0[2], g0[3]}, (f32x2){u0[2], u0[3]});
                    const f32x2 p2 = silu_mul_pk((f32x2){g1[0], g1[1]}, (f32x2){u1[0], u1[1]}), p3 = silu_mul_pk((f32x2){g1[2], g1[3]}, (f32x2){u1[2], u1[3]});
                    u32x4 w; w.x = pk2(p0.x, p0.y); w.y = pk2(p1.x, p1.y); w.z = pk2(p2.x, p2.y); w.w = pk2(p3.x, p3.y);
                    __builtin_nontemporal_store(w, (u32x4*)rowp); } }
    }
};
constexpr float Y8_SCALE = 16.0f, Y8_INV = 1.0f / 16.0f;
struct EpiMoeDown {
    static constexpr bool PERM = true; static constexpr int PROBE_ID = 11;
    unsigned char* Y; const float* gsort; const volatile LAS int* tb;
    __device__ __forceinline__ void operator()(const f32x4 (&acc)[2][2][4][2], const Unit& u, int wr, int wc, int fr, int fq) const {
        const int lrow0 = wr * 64 + fr, col0 = u.pn * BM + wc * 32 + 8 * fq; const int p0 = (u.pm - __builtin_amdgcn_readfirstlane(tb[u.e])) * 256, n = __builtin_amdgcn_readfirstlane(tb[16 + u.e]);
        float gws[2][4];
#pragma unroll
        for (int ai = 0; ai < 2; ++ai)
#pragma unroll
            for (int m = 0; m < 4; ++m) { const int pp = p0 + lrow0 + ai * HALF + m * 16; gws[ai][m] = gsort[u.e * T + (pp < n ? pp : n - 1)]; }
#pragma unroll
        for (int ai = 0; ai < 2; ++ai)
#pragma unroll
            for (int m = 0; m < 4; ++m) { const int lr = lrow0 + ai * HALF + m * 16; const float gw = gws[ai][m] * (W8_INV * Y8_SCALE);
                unsigned char* rowp = Y + (size_t)(u.pm * 256 + lr) * D + col0;
#pragma unroll
                for (int bj = 0; bj < 2; ++bj) { const f32x4 v0 = acc[ai][bj][m][0] * gw, v1 = acc[ai][bj][m][1] * gw;
                    u32x2 w; w.x = pk4_fp8(v0[0], v0[1], v0[2], v0[3]); w.y = pk4_fp8(v1[0], v1[1], v1[2], v1[3]);
                    *(u32x2*)(rowp + bj * HALF) = w; } }
    }
};

template <class Epi, class Sched, bool GATHER, bool ALIGN_EPI, bool SP2, bool FP8>
__device__ __forceinline__ void gemm_phase(LAS unsigned char* lds, const Sched& S, const Epi& E, const int Kb, const int lda, const int ldb) {
    int tid_ = threadIdx.x; asm volatile("" : "+v"(tid_));
    const int tid = tid_, wid = __builtin_amdgcn_readfirstlane(tid >> 6), lane = tid & 63, wr = wid >> 2, wc = wid & 3, fr = lane & 15, fq = lane >> 4;
    int nt_ = Kb / 128; asm volatile("" : "+s"(nt_)); const int nt = nt_;
    unsigned voffA[2][2], voffB[2];
#pragma unroll
    for (int i = 0; i < 2; ++i) { int R, C; stage_rc(tid * 16 + i * 8192, R, C); const int Rb = Epi::PERM ? ((R & ~31) + perm32(R & 31)) : R;
        voffA[0][i] = (unsigned)(R * lda + 2 * C); voffA[1][i] = 0u; voffB[i] = (unsigned)(Rb * ldb + 2 * C); }
    constexpr int kstep = BK * 2;
    const int hstepB = HALF * ldb;
    const int hstepA = GATHER ? 0 : HALF * lda;
    const unsigned ldsw = (unsigned)wid * 1024u;
    const int aoff = lds_byte(wr * 64 + fr, fq * 8), boff = lds_byte(wc * 32 + fr, fq * 8);
#define PG8_SA(b, h) (((b) * 2 + (h)) * HTB)
#define PG8_SB(b, h) ((4 + (b) * 2 + (h)) * HTB)
#define PG8_STAGE(bufoff, gbase, voff) do { _Pragma("unroll") for (int _i = 0; _i < 2; ++_i) \
        __builtin_amdgcn_global_load_lds((const unsigned*)((const char*)(gbase) + (voff)[_i]), (LAS unsigned*)(lds + (bufoff) + ldsw + _i * 8192), 16, 0, 0); } while (0)
#define PG8_LDA(dst, b, h) do { _Pragma("unroll") for (int m = 0; m < 4; ++m) { const LAS i32x4* _p = (const LAS i32x4*)(lds + PG8_SA(b, h) + aoff + m * 2048); const i32x4 _lo = _p[0], _hi = _p[64]; \
        dst[m] = __builtin_shufflevector(_lo, _hi, 0, 1, 2, 3, 4, 5, 6, 7); } } while (0)
#define PG8_LDB(dst, b, h) do { _Pragma("unroll") for (int n = 0; n < 2; ++n) { const LAS i32x4* _p = (const LAS i32x4*)(lds + PG8_SB(b, h) + boff + n * 2048); const i32x4 _lo = _p[0], _hi = _p[64]; \
        dst[n] = __builtin_shufflevector(_lo, _hi, 0, 1, 2, 3, 4, 5, 6, 7); } } while (0)
#define PG8_MMA(ai, bj, At, Bt) do { __builtin_amdgcn_s_setprio(1); _Pragma("unroll") for (int m = 0; m < 4; ++m) _Pragma("unroll") for (int n = 0; n < 2; ++n) { \
        if constexpr (FP8) { asm volatile("v_mfma_scale_f32_16x16x128_f8f6f4 %0, %1, %2, %0, %3, %3 op_sel_hi:[0,0,0]" : "+v"(acc[ai][bj][m][n]) : "v"(Bt[n]), "v"(At[m]), "v"(one8)); } \
        else { acc[ai][bj][m][n] = __builtin_amdgcn_mfma_f32_16x16x32_bf16(__builtin_bit_cast(bf16x8, __builtin_shufflevector(Bt[n], Bt[n], 0, 1, 2, 3)), __builtin_bit_cast(bf16x8, __builtin_shufflevector(At[m], At[m], 0, 1, 2, 3)), acc[ai][bj][m][n], 0, 0, 0); \
               acc[ai][bj][m][n] = __builtin_amdgcn_mfma_f32_16x16x32_bf16(__builtin_bit_cast(bf16x8, __builtin_shufflevector(Bt[n], Bt[n], 4, 5, 6, 7)), __builtin_bit_cast(bf16x8, __builtin_shufflevector(At[m], At[m], 4, 5, 6, 7)), acc[ai][bj][m][n], 0, 0, 0); } } \
        __builtin_amdgcn_s_setprio(0); } while (0)
#define PG8_WAIT_V(n) asm volatile("s_waitcnt vmcnt(" #n ")" ::: "memory")
#define PG8_WAIT_L(n) asm volatile("s_waitcnt lgkmcnt(" #n ")" ::: "memory")
#define PG8_BAR __builtin_amdgcn_s_barrier()
#define PG8_SCHED __builtin_amdgcn_sched_barrier(0)
#define PG8_GOFF(dst, unit) do { _Pragma("unroll") for (int _i = 0; _i < 2; ++_i) { int _R, _C; stage_rc(tid * 16 + _i * 8192, _R, _C); \
        dst[0][_i] = (unsigned)(S.grow(unit, _R) * lda + 2 * _C); dst[1][_i] = (unsigned)(S.grow(unit, _R + HALF) * lda + 2 * _C); } } while (0)
    Unit cur, nxt; int ui = 0;
    if (!S.next(0, cur)) return;
    f32x4 acc[2][2][4][2];
#pragma unroll
    for (int a = 0; a < 2; ++a)
#pragma unroll
        for (int b = 0; b < 2; ++b)
#pragma unroll
            for (int m = 0; m < 4; ++m)
#pragma unroll
                for (int n = 0; n < 2; ++n) acc[a][b][m][n] = (f32x4){0.f, 0.f, 0.f, 0.f};
    int one8 = 0x7F7F7F7F; asm volatile("" : "+v"(one8));
    i32x8 At[4], B0[2], B1[2];
    const char* cA = S.a_base(cur); const char* cB = S.b_base(cur);
    if constexpr (GATHER) { PG8_GOFF(voffA, cur); }
    if constexpr (SP2) {
        PG8_STAGE(PG8_SB(0, 0), cB, voffB); PG8_STAGE(PG8_SB(0, 1), cB + hstepB, voffB); PG8_STAGE(PG8_SA(0, 0), cA, voffA[0]); PG8_STAGE(PG8_SA(0, 1), cA + hstepA, voffA[GATHER ? 1 : 0]);
        if (wr == 1) PG8_BAR;
        PG8_WAIT_V(2); PG8_BAR;
        PG8_STAGE(PG8_SB(1, 0), cB + kstep, voffB); PG8_STAGE(PG8_SA(1, 0), cA + kstep, voffA[0]); PG8_STAGE(PG8_SB(1, 1), cB + hstepB + kstep, voffB);
        PG8_WAIT_V(6); PG8_BAR;
    } else {
        PG8_STAGE(PG8_SB(0, 0), cB, voffB); PG8_STAGE(PG8_SA(0, 0), cA, voffA[0]); PG8_STAGE(PG8_SB(0, 1), cB + hstepB, voffB); PG8_STAGE(PG8_SA(0, 1), cA + hstepA, voffA[GATHER ? 1 : 0]);
        if (wr == 1) PG8_BAR;
        PG8_WAIT_V(4); PG8_BAR;
        PG8_STAGE(PG8_SB(1, 0), cB + kstep, voffB); PG8_STAGE(PG8_SA(1, 0), cA + kstep, voffA[0]); PG8_STAGE(PG8_SB(1, 1), cB + hstepB + kstep, voffB);
        PG8_WAIT_V(6); PG8_BAR;
    }
    for (;;) {
        const bool has_next = S.next(ui + 1, nxt);
        const char* nA = has_next ? S.a_base(nxt) : cA; const char* nB = has_next ? S.b_base(nxt) : cB;
        if constexpr (GATHER) { if (has_next && wid < 4)
            __builtin_amdgcn_global_load_lds((const unsigned*)S.gptr(nxt, wid * 64 + lane), (LAS unsigned*)(lds + IDX_OFF + ((ui + 1) & 1) * 1024 + wid * 256), 4, 0, 0); }
        asm volatile(".p2align 8" :::);
        for (int t = 0; t < nt; t += 2) {
            const bool last = (t == nt - 2);
            const char* a1 = cA + (t + 1) * kstep;
            const char* a2 = last ? nA : cA + (t + 2) * kstep; const char* b2 = last ? nB : cB + (t + 2) * kstep;
            const char* a3 = a2 + kstep; const char* b3 = b2 + kstep;
            unsigned nv[2][2];
            if constexpr (GATHER) { if (last && has_next) {
                const LAS int* ix = (const LAS int*)(lds + IDX_OFF) + ((ui + 1) & 1) * 256;
#pragma unroll
                for (int _i = 0; _i < 2; ++_i) { int _R, _C; stage_rc(tid * 16 + _i * 8192, _R, _C); nv[0][_i] = (unsigned)(ix[_R] * lda + 2 * _C); nv[1][_i] = (unsigned)(ix[_R + HALF] * lda + 2 * _C); } } }
            if constexpr (SP2) {
            PG8_LDB(B0, 0, 0); PG8_LDB(B1, 0, 1); PG8_SCHED; PG8_LDA(At, 0, 0); PG8_STAGE(PG8_SA(1, 1), a1 + hstepA, voffA[GATHER ? 1 : 0]);
            if constexpr (GATHER) { if (last && has_next) { voffA[0][0] = nv[0][0]; voffA[0][1] = nv[0][1]; voffA[1][0] = nv[1][0]; voffA[1][1] = nv[1][1]; } }
            PG8_WAIT_V(8); PG8_WAIT_L(0); PG8_BAR; PG8_MMA(0, 0, At, B0); PG8_MMA(0, 1, At, B1); PG8_BAR; PG8_SCHED;
            PG8_LDA(At, 0, 1); PG8_STAGE(PG8_SB(0, 0), b2, voffB); PG8_STAGE(PG8_SB(0, 1), b2 + hstepB, voffB); PG8_STAGE(PG8_SA(0, 0), a2, voffA[0]);
            PG8_WAIT_V(8); PG8_WAIT_L(0); PG8_BAR; PG8_MMA(1, 0, At, B0); PG8_MMA(1, 1, At, B1); PG8_BAR; PG8_SCHED;
            PG8_LDB(B0, 1, 0); PG8_LDB(B1, 1, 1); PG8_SCHED; PG8_LDA(At, 1, 0); PG8_STAGE(PG8_SA(0, 1), a2 + hstepA, voffA[GATHER ? 1 : 0]);
            PG8_WAIT_V(8); PG8_WAIT_L(0); PG8_BAR; PG8_MMA(0, 0, At, B0); PG8_MMA(0, 1, At, B1); PG8_BAR; PG8_SCHED;
            PG8_LDA(At, 1, 1); PG8_STAGE(PG8_SB(1, 0), b3, voffB); PG8_STAGE(PG8_SB(1, 1), b3 + hstepB, voffB); PG8_STAGE(PG8_SA(1, 0), a3, voffA[0]);
            PG8_WAIT_V(8); PG8_WAIT_L(0); PG8_BAR; PG8_MMA(1, 0, At, B0); PG8_MMA(1, 1, At, B1); PG8_BAR; PG8_SCHED;
            } else {
            PG8_LDB(B0, 0, 0); PG8_SCHED; PG8_LDA(At, 0, 0); PG8_STAGE(PG8_SA(1, 1), a1 + hstepA, voffA[GATHER ? 1 : 0]);
            if constexpr (GATHER) { if (last && has_next) { voffA[0][0] = nv[0][0]; voffA[0][1] = nv[0][1]; voffA[1][0] = nv[1][0]; voffA[1][1] = nv[1][1]; } }
            PG8_WAIT_L(8); PG8_BAR; PG8_WAIT_L(0); PG8_MMA(0, 0, At, B0); PG8_BAR; PG8_SCHED;
            PG8_LDB(B1, 0, 1); PG8_STAGE(PG8_SB(0, 0), b2, voffB);
            PG8_BAR; PG8_WAIT_L(0); PG8_MMA(0, 1, At, B1); PG8_BAR;
            PG8_LDA(At, 0, 1); PG8_STAGE(PG8_SA(0, 0), a2, voffA[0]);
            PG8_BAR; PG8_WAIT_L(0); PG8_MMA(1, 0, At, B0); PG8_BAR; PG8_SCHED;
            PG8_STAGE(PG8_SB(0, 1), b2 + hstepB, voffB);
            PG8_WAIT_V(6); PG8_BAR; PG8_MMA(1, 1, At, B1); PG8_BAR;
            PG8_LDB(B0, 1, 0); PG8_SCHED; PG8_LDA(At, 1, 0); PG8_STAGE(PG8_SA(0, 1), a2 + hstepA, voffA[GATHER ? 1 : 0]);
            PG8_WAIT_L(8); PG8_BAR; PG8_WAIT_L(0); PG8_MMA(0, 0, At, B0); PG8_BAR; PG8_SCHED;
            PG8_LDB(B1, 1, 1); PG8_STAGE(PG8_SB(1, 0), b3, voffB);
            PG8_BAR; PG8_WAIT_L(0); PG8_MMA(0, 1, At, B1); PG8_BAR;
            PG8_LDA(At, 1, 1); PG8_STAGE(PG8_SA(1, 0), a3, voffA[0]);
            PG8_BAR; PG8_WAIT_L(0); PG8_MMA(1, 0, At, B0); PG8_BAR; PG8_SCHED;
            PG8_STAGE(PG8_SB(1, 1), b3 + hstepB, voffB);
            PG8_WAIT_V(6); PG8_BAR; PG8_MMA(1, 1, At, B1); PG8_BAR;
            }
        }
        if constexpr (FP8) {
            asm volatile("s_nop 15\n\ts_nop 7" ::: "memory");
#pragma unroll
            for (int a = 0; a < 2; ++a)
#pragma unroll
                for (int b = 0; b < 2; ++b) asm volatile("" : "+v"(acc[a][b][0][0]), "+v"(acc[a][b][0][1]), "+v"(acc[a][b][1][0]), "+v"(acc[a][b][1][1]), "+v"(acc[a][b][2][0]), "+v"(acc[a][b][2][1]), "+v"(acc[a][b][3][0]), "+v"(acc[a][b][3][1]));
        }
        if constexpr (ALIGN_EPI) { if (wr == 0) PG8_BAR; }
        E(acc, cur, wr, wc, fr, fq);
#if PROBE_REPEAT == 105
        if constexpr (Epi::PROBE_ID == 5) { asm volatile("s_waitcnt vmcnt(0)" ::: "memory"); E(acc, cur, wr, wc, fr, fq); }
#endif
        if (!has_next) break;
#pragma unroll
        for (int a = 0; a < 2; ++a)
#pragma unroll
            for (int b = 0; b < 2; ++b)
#pragma unroll
                for (int m = 0; m < 4; ++m)
#pragma unroll
                    for (int n = 0; n < 2; ++n) acc[a][b][m][n] = (f32x4){0.f, 0.f, 0.f, 0.f};
        cur = nxt; cA = nA; cB = nB; ++ui;
        if constexpr (FP8) asm volatile("s_nop 3" ::: "memory");
        if constexpr (ALIGN_EPI) { if (wr == 1) PG8_BAR; }
    }
    PG8_WAIT_V(0);
    if constexpr (!ALIGN_EPI) { if (wr == 0) PG8_BAR; }
    PG8_BAR;
#undef PG8_SA
#undef PG8_SB
#undef PG8_STAGE
#undef PG8_LDA
#undef PG8_LDB
#undef PG8_MMA
#undef PG8_WAIT_V
#undef PG8_WAIT_L
#undef PG8_BAR
#undef PG8_SCHED
#undef PG8_GOFF
}
}

struct TItem { const float* src; void* dst; const float* gk; int N, K, k0, n0, drow0, f8; };
__device__ __forceinline__ void titem_load(const TItem& t, f32x4 (&r)[16], int lane) {
    const float* p = t.src + (size_t)(t.k0 + (lane >> 4)) * t.N + t.n0 + 4 * (lane & 15);
#pragma unroll
    for (int i = 0; i < 16; ++i) r[i] = __builtin_nontemporal_load((const f32x4*)(p + (size_t)(4 * i) * t.N));
}
__device__ __forceinline__ void titem_to_lds(const f32x4 (&r)[16], LAS float* scr, int lane) {
    LAS float* q = scr + (lane >> 4) * 65 + 4 * (lane & 15);
#pragma unroll
    for (int i = 0; i < 16; ++i) { q[(4 * i) * 65 + 0] = r[i].x; q[(4 * i) * 65 + 1] = r[i].y; q[(4 * i) * 65 + 2] = r[i].z; q[(4 * i) * 65 + 3] = r[i].w; }
}
__device__ __forceinline__ void titem_store(const TItem& t, const LAS float* scr, int lane) {
    if (t.f8) { const int c = lane & 3; unsigned char* WT = (unsigned char*)t.dst;
#pragma unroll
        for (int j = 0; j < 4; ++j) { const int n = (lane >> 2) + 16 * j; const LAS float* s = scr + (16 * c) * 65 + n;
            u32x4 o; o.x = pk4_fp8(s[0 * 65] * W8_SCALE, s[1 * 65] * W8_SCALE, s[2 * 65] * W8_SCALE, s[3 * 65] * W8_SCALE); o.y = pk4_fp8(s[4 * 65] * W8_SCALE, s[5 * 65] * W8_SCALE, s[6 * 65] * W8_SCALE, s[7 * 65] * W8_SCALE);
            o.z = pk4_fp8(s[8 * 65] * W8_SCALE, s[9 * 65] * W8_SCALE, s[10 * 65] * W8_SCALE, s[11 * 65] * W8_SCALE); o.w = pk4_fp8(s[12 * 65] * W8_SCALE, s[13 * 65] * W8_SCALE, s[14 * 65] * W8_SCALE, s[15 * 65] * W8_SCALE);
            __builtin_nontemporal_store(o, (u32x4*)(WT + (size_t)(t.drow0 + n) * t.K + t.k0 + 16 * c));     }
    } else { const int c = lane & 7; bf16_t* WT = (bf16_t*)t.dst;
#pragma unroll
        for (int j = 0; j < 8; ++j) { const int n = (lane >> 3) + 8 * j; const LAS float* s = scr + (8 * c) * 65 + n;
            f32x4 ga = (f32x4){1.f, 1.f, 1.f, 1.f}, gb = ga;
            if (t.gk) { ga = *(const f32x4*)(t.gk + t.k0 + 8 * c); gb = *(const f32x4*)(t.gk + t.k0 + 8 * c + 4); }
            u32x4 o; o.x = pk2(s[0 * 65] * ga.x, s[1 * 65] * ga.y); o.y = pk2(s[2 * 65] * ga.z, s[3 * 65] * ga.w); o.z = pk2(s[4 * 65] * gb.x, s[5 * 65] * gb.y); o.w = pk2(s[6 * 65] * gb.z, s[7 * 65] * gb.w);
            *(u32x4*)(WT + (size_t)(t.drow0 + n) * t.K + t.k0 + 8 * c) = o; }
    }
}
constexpr int CI_QKV = 16 * 24, CI_O = 16 * 16, CI_G = 16 * 44, CI_D = 44 * 16, CI_P = 4 * 16, CI_MG = 16 * 56, CI_MD = 56 * 16;
constexpr int CONV_L0 = CI_QKV + CI_O + 2 * CI_G + CI_D + CI_P, CONV_ALL = CONV_L0 + NE * (2 * CI_MG + CI_MD);
#ifndef CFG_F1
#define CFG_F1 13
#define CFG_NCONV2 10
#define CFG_X2 29
#endif
constexpr int CONV_P1 = CONV_L0 + (int)((long)(CONV_ALL - CONV_L0) * CFG_F1 / 32);
struct ConvPtrs { const float *wqkv, *wo, *wg, *wu, *wd, *wp, *mg, *mu, *md; bf16_t *Wqkv, *Wo, *Wgu, *Wd, *Wp; unsigned char *Mgu, *Md; const float *g_attn, *g_ffn; };
__device__ __forceinline__ void conv_decode(const ConvPtrs& P, int item, TItem& t) {
    int it = item, inter = 0, ioff = 0; t.f8 = 0; t.gk = nullptr;
    if (it < CI_QKV) { t.src = P.wqkv; t.dst = P.Wqkv; t.K = D; t.N = QKVW; t.gk = P.g_attn; }
    else if ((it -= CI_QKV) < CI_O) { t.src = P.wo; t.dst = P.Wo; t.K = D; t.N = D; }
    else if ((it -= CI_O) < CI_G) { t.src = P.wg; t.dst = P.Wgu; t.K = D; t.N = DFF; inter = 1; t.gk = P.g_ffn; }
    else if ((it -= CI_G) < CI_G) { t.src = P.wu; t.dst = P.Wgu; t.K = D; t.N = DFF; inter = 1; ioff = 128; t.gk = P.g_ffn; }
    else if ((it -= CI_G) < CI_D) { t.src = P.wd; t.dst = P.Wd; t.K = DFF; t.N = D; }
    else if ((it -= CI_D) < CI_P) { const int g = it / 16; it %= 16; t.src = P.wp + (size_t)g * 256 * 256; t.dst = P.Wp + (size_t)g * 256 * 256; t.K = 256; t.N = 256; }
    else { it -= CI_P; const int per = 2 * CI_MG + CI_MD, e = it / per; it %= per; t.f8 = 1;
        if (it < CI_MG) { t.src = P.mg + (size_t)e * D * DFE; t.dst = P.Mgu + (size_t)e * 2 * DFE * D; t.K = D; t.N = DFE; inter = 1; }
        else if ((it -= CI_MG) < CI_MG) { t.src = P.mu + (size_t)e * D * DFE; t.dst = P.Mgu + (size_t)e * 2 * DFE * D; t.K = D; t.N = DFE; inter = 1; ioff = 128; }
        else { it -= CI_MG; t.src = P.md + (size_t)e * DFE * D; t.dst = P.Md + (size_t)e * D * DFE; t.K = DFE; t.N = D; } }
    const int nnb = t.N / 64, kb = it / nnb, nb = it % nnb; t.k0 = kb * 64; t.n0 = nb * 64;
    t.drow0 = inter ? ((t.n0 >> 7) * 256 + ioff + (t.n0 & 127)) : t.n0;
}
__device__ __forceinline__ void conv_run(LAS unsigned char* lds, const ConvPtrs& P, int lo, int hi, int nblk, int vbid) {
    const int tid0 = opaque_tid(), lane = tid0 & 63, wave = __builtin_amdgcn_readfirstlane(tid0 >> 6), gw = vbid * 8 + wave, ngw = nblk * 8;
    LAS float* scr = (LAS float*)(lds + wave * 16640);
    if (lo + gw < hi) {
        TItem cur, nxt; f32x4 r[16]; int item = lo + gw;
        conv_decode(P, item, cur); titem_load(cur, r, lane);
        for (;;) {
            titem_to_lds(r, scr, lane);
            const int ni = item + ngw; const bool has = ni < hi;
            if (has) { conv_decode(P, ni, nxt); titem_load(nxt, r, lane); }
            LDS_WAIT(); asm volatile("" ::: "memory");
            titem_store(cur, scr, lane);
            LDS_WAIT(); asm volatile("" ::: "memory");
            if (!has) break;
            cur = nxt; item = ni;
        }
    }
}
__device__ __forceinline__ void xcopy_rows2(const float* x0, const float* x1, bool two, bf16_t* o0, bf16_t* o1, float* r0, float* r1, int lane) {
    const f32x4* xa = (const f32x4*)x0 + lane; const f32x4* xb = (const f32x4*)x1 + lane;
    f32x4 va[4], vb[4]; float sa = 0.f, sb = 0.f;
#pragma unroll
    for (int j = 0; j < 4; ++j) { va[j] = xa[64 * j]; vb[j] = xb[64 * j]; }
#pragma unroll
    for (int j = 0; j < 4; ++j) { sa += (va[j].x * va[j].x + va[j].y * va[j].y) + (va[j].z * va[j].z + va[j].w * va[j].w); sb += (vb[j].x * vb[j].x + vb[j].y * vb[j].y) + (vb[j].z * vb[j].z + vb[j].w * vb[j].w); }
    const float ra = 1.0f / sqrtf(wave_sum(sa) * (1.f / D) + RMS_EPS), rb = 1.0f / sqrtf(wave_sum(sb) * (1.f / D) + RMS_EPS);
    u32x2* pa = (u32x2*)o0 + lane; u32x2* pb = (u32x2*)o1 + lane;
#pragma unroll
    for (int j = 0; j < 4; ++j) { u32x2 w; w.x = pk2(va[j].x, va[j].y); w.y = pk2(va[j].z, va[j].w); pa[64 * j] = w; }
    if (lane == 0) *r0 = ra;
    if (two) {
#pragma unroll
        for (int j = 0; j < 4; ++j) { u32x2 w; w.x = pk2(vb[j].x, vb[j].y); w.y = pk2(vb[j].z, vb[j].w); pb[64 * j] = w; }
        if (lane == 0) *r1 = rb; }
}
__device__ __forceinline__ void xcopy_phase(const float* X, bf16_t* O, float* R, int G, int bid) {
    const int tid = opaque_tid(), lane = tid & 63, gw = bid * 8 + __builtin_amdgcn_readfirstlane(tid >> 6), ngw = G * 8;
    for (int m = gw; m < T; m += 2 * ngw) { const int m1 = m + ngw; const bool two = m1 < T; const int mb = two ? m1 : m;
        xcopy_rows2(X + (size_t)m * D, X + (size_t)mb * D, two, O + (size_t)m * D, O + (size_t)mb * D, R + m, R + mb, lane); }
}

__device__ __forceinline__ unsigned ks_off(int key, int c) { return (unsigned)(key * 128 + ((c ^ ((key >> 1) & 7)) << 4)); }
__device__ __forceinline__ unsigned vs_off(int key, int c) { return (unsigned)(key * 128 + ((c ^ (((key >> 1) & 1) << 2)) << 4)); }
template <int OFF> __device__ __forceinline__ void tr_read4(s16x4& a, s16x4& b, s16x4& c, s16x4& d, unsigned b0, unsigned b1) {
    asm volatile("ds_read_b64_tr_b16 %0, %4 offset:%6\n\tds_read_b64_tr_b16 %1, %4 offset:%7\n\tds_read_b64_tr_b16 %2, %5 offset:%6\n\tds_read_b64_tr_b16 %3, %5 offset:%7\n\ts_waitcnt lgkmcnt(0)"
                 : "=&v"(a), "=&v"(b), "=&v"(c), "=&v"(d) : "v"(b0), "v"(b1), "i"(OFF), "i"(OFF + 1024) : "memory");
}
__device__ __forceinline__ void attn_phase(LAS unsigned char* lds, const bf16_t* QKV, bf16_t* O, const float* sinks, int G, int bid) {
    const int tid = opaque_tid(), lane = tid & 63, wid = __builtin_amdgcn_readfirstlane(tid >> 6);
    const int g = wid >> 1, half = wid & 1, ql = lane & 31, h = lane >> 5;
    LAS unsigned char* Ks = lds; LAS unsigned char* Vs = lds + 32768;
    const int i16 = lane & 15, tq = i16 >> 2, tp = i16 & 3, blk = (lane >> 4) & 1;
    for (int u = bid; u < BATCH * 32 * NKV; u += G) {
        const int kvh = u & 3, bn = u >> 2, n = bn & 31, b = bn >> 5;
        const int tok0 = b * SEQ + n * 128;
        __syncthreads();
#pragma unroll
        for (int i = 0; i < 4; ++i) { const int q = tid + 512 * i, row = q >> 3, c = q & 7; const bool valid = (n > 0) || (row >= 128);
            u32x4 kv = (u32x4){0u, 0u, 0u, 0u}, vv = (u32x4){0u, 0u, 0u, 0u};
            if (valid) { const bf16_t* p = QKV + (size_t)(tok0 - 128 + row) * QKVW + 1024 + kvh * 64 + c * 8; kv = *(const u32x4*)p; vv = *(const u32x4*)(p + 256); }
            *(LAS u32x4*)(Ks + ks_off(row, c)) = kv; *(LAS u32x4*)(Vs + vs_off(row, c)) = vv; }
        __syncthreads();
        const int hq = kvh * 4 + g;
        const float slope2 = __builtin_amdgcn_exp2f(-0.5f * (float)(hq + 1)) * LOG2E, sink2 = sinks[hq] * LOG2E;
#pragma unroll 1
        for (int sub = 0; sub < 2; ++sub) {
            const int r0 = half * 64 + sub * 32, c0 = r0 >> 5, r = r0 + ql;
            const bf16_t* qp = QKV + (size_t)(tok0 + r) * QKVW + hq * 64 + 8 * h;
            bf16x8 qf[4];
#pragma unroll
            for (int kk = 0; kk < 4; ++kk) qf[kk] = *(const bf16x8*)(qp + 16 * kk);
            const LAS unsigned char* kb0 = Ks + c0 * 4096 + ks_off(ql, 0 + h); const LAS unsigned char* kb1 = Ks + c0 * 4096 + ks_off(ql, 2 + h);
            const LAS unsigned char* kb2 = Ks + c0 * 4096 + ks_off(ql, 4 + h); const LAS unsigned char* kb3 = Ks + c0 * 4096 + ks_off(ql, 6 + h);
            f32x16 S[5];
#pragma unroll
            for (int ck = 0; ck < 5; ++ck) {
#pragma unroll
                for (int i = 0; i < 16; ++i) S[ck][i] = 0.f;
                S[ck] = __builtin_amdgcn_mfma_f32_32x32x16_bf16(*(const LAS bf16x8*)(kb0 + 4096 * ck), qf[0], S[ck], 0, 0, 0);
                S[ck] = __builtin_amdgcn_mfma_f32_32x32x16_bf16(*(const LAS bf16x8*)(kb1 + 4096 * ck), qf[1], S[ck], 0, 0, 0);
                S[ck] = __builtin_amdgcn_mfma_f32_32x32x16_bf16(*(const LAS bf16x8*)(kb2 + 4096 * ck), qf[2], S[ck], 0, 0, 0);
                S[ck] = __builtin_amdgcn_mfma_f32_32x32x16_bf16(*(const LAS bf16x8*)(kb3 + 4096 * ck), qf[3], S[ck], 0, 0, 0);
            }
            const int bd = 128 + ql - 4 * h, jb = 32 * c0 + 4 * h; const float nb = -slope2 * (float)bd;
            float mxr = -1e30f;
            if (n > 0) {
#pragma unroll
                for (int ck = 0; ck < 5; ++ck)
#pragma unroll
                    for (int i = 0; i < 16; ++i) { const int kc = 32 * ck + (i & 3) + 8 * (i >> 2);
                        float s = __builtin_fmaf(slope2, (float)kc, S[ck][i]);
                        if (ck == 0) s = (kc > bd - 128) ? s : -1e30f;
                        if (ck == 4) s = (kc <= bd) ? s : -1e30f;
                        S[ck][i] = s; mxr = fmaxf(mxr, s); }
            } else {
#pragma unroll
                for (int ck = 0; ck < 5; ++ck)
#pragma unroll
                    for (int i = 0; i < 16; ++i) { const int kc = 32 * ck + (i & 3) + 8 * (i >> 2);
                        const bool valid = (kc <= bd) && (kc > bd - 128) && (jb + kc >= 128);
                        const float s = valid ? __builtin_fmaf(slope2, (float)kc, S[ck][i]) : -1e30f; S[ck][i] = s; mxr = fmaxf(mxr, s); }
            }
            float mt = mxr + nb; mt = fmaxf(mt, __shfl_xor(mt, 32));
            const float mx = fmaxf(mt, sink2), mm = mx - nb;
            float l = 0.f;
            bf16x8 pf[5][2];
#pragma unroll
            for (int ck = 0; ck < 5; ++ck)
#pragma unroll
                for (int s = 0; s < 2; ++s) { float p[8];
#pragma unroll
                    for (int i = 0; i < 8; ++i) { p[i] = __builtin_amdgcn_exp2f(S[ck][8 * s + i] - mm); l += p[i]; }
                    u32x4 pw; pw.x = pk2(p[0], p[1]); pw.y = pk2(p[2], p[3]); pw.z = pk2(p[4], p[5]); pw.w = pk2(p[6], p[7]);
                    pf[ck][s] = __builtin_bit_cast(bf16x8, pw); }
            l += __shfl_xor(l, 32); l += __builtin_amdgcn_exp2f(sink2 - mx);
            const float inv = 1.0f / l;
            f32x16 o0, o1;
#pragma unroll
            for (int i = 0; i < 16; ++i) { o0[i] = 0.f; o1[i] = 0.f; }
            const unsigned vb0 = (unsigned)(size_t)Vs + c0 * 4096 + vs_off(4 * h + tq, 2 * blk + (tp >> 1)) + 8 * (tp & 1);
            const unsigned vb1 = (unsigned)(size_t)Vs + c0 * 4096 + vs_off(4 * h + tq, 4 + 2 * blk + (tp >> 1)) + 8 * (tp & 1);
#define ATT_PV(ck, s) do { s16x4 lo0, hi0, lo1, hi1; tr_read4<4096 * (ck) + 2048 * (s)>(lo0, hi0, lo1, hi1, vb0, vb1); \
                const bf16x8 v0 = __builtin_shufflevector(lo0, hi0, 0, 1, 2, 3, 4, 5, 6, 7), v1 = __builtin_shufflevector(lo1, hi1, 0, 1, 2, 3, 4, 5, 6, 7); \
                o0 = __builtin_amdgcn_mfma_f32_32x32x16_bf16(v0, pf[ck][s], o0, 0, 0, 0); o1 = __builtin_amdgcn_mfma_f32_32x32x16_bf16(v1, pf[ck][s], o1, 0, 0, 0); } while (0)
            ATT_PV(0, 0); ATT_PV(0, 1); ATT_PV(1, 0); ATT_PV(1, 1); ATT_PV(2, 0); ATT_PV(2, 1); ATT_PV(3, 0); ATT_PV(3, 1); ATT_PV(4, 0); ATT_PV(4, 1);
#undef ATT_PV
            bf16_t* op = O + (size_t)(tok0 + r) * D + hq * 64 + 4 * h;
#pragma unroll
            for (int g4 = 0; g4 < 4; ++g4) {
                u32x2 w0; w0.x = pk2(o0[4 * g4 + 0] * inv, o0[4 * g4 + 1] * inv); w0.y = pk2(o0[4 * g4 + 2] * inv, o0[4 * g4 + 3] * inv);
                u32x2 w1; w1.x = pk2(o1[4 * g4 + 0] * inv, o1[4 * g4 + 1] * inv); w1.y = pk2(o1[4 * g4 + 2] * inv, o1[4 * g4 + 3] * inv);
                *(u32x2*)(op + 8 * g4) = w0; *(u32x2*)(op + 32 + 8 * g4) = w1; }
        }
    }
}

template <int W> __device__ __forceinline__ void pool_pass_b(const bf16_t* xc, const LAS float* rs, const f32x4 gn, bf16_t* pout, int base, int rmin, int spos0) {
    f32x4 hist[16];
#pragma unroll
    for (int j = 0; j < 16; ++j) hist[j] = (f32x4){0.f, 0.f, 0.f, 0.f};
    f32x4 S = (f32x4){0.f, 0.f, 0.f, 0.f};
    u32x2 nxt[8];
#pragma unroll
    for (int k = 0; k < 8; ++k) { const int r = base - 16 + k, rc = r < rmin ? rmin : r; nxt[k] = *(const u32x2*)(xc + (long)rc * D); }
#pragma unroll 1
    for (int rb = base - 16; rb < base + 64; rb += 8) {
        f32x4 cur[8];
#pragma unroll
        for (int k = 0; k < 8; ++k) cur[k] = unpack4(nxt[k]);
        if (rb + 8 < base + 64) {
#pragma unroll
            for (int k = 0; k < 8; ++k) { const int r = rb + 8 + k, rc = r < rmin ? rmin : r; nxt[k] = *(const u32x2*)(xc + (long)rc * D); } }
#pragma unroll
        for (int k = 0; k < 8; ++k) { const int r = rb + k, rc = r < rmin ? rmin : r;
            f32x4 hv = cur[k] * rs[rc + 16] * gn;
            if (r < rmin) hv = (f32x4){0.f, 0.f, 0.f, 0.f};
            cur[k] = hv;
            const f32x4 ho = (k - W >= 0) ? cur[(k - W >= 0) ? k - W : 0] : hist[(16 + k - W) & 15];
            S += hv; S -= ho;
            if (r >= base) { const int pos = spos0 + r + 1; const float inv = 1.0f / (float)(pos < W ? pos : W); const f32x4 pv = S * inv - hv;
                u32x2 o; o.x = pk2(pv.x, pv.y); o.y = pk2(pv.z, pv.w); *(u32x2*)(pout + (size_t)r * D) = o; } }
#pragma unroll
        for (int j = 0; j < 8; ++j) { hist[j] = hist[j + 8]; hist[j + 8] = cur[j]; }
    }
}
__device__ __forceinline__ void pool_phase(LAS unsigned char* lds, const bf16_t* X, const float* ssq, const float* gain, bf16_t* P, int G, int bid) {
    const int tid = opaque_tid(), lane = tid & 63, wid = __builtin_amdgcn_readfirstlane(tid >> 6);
    LAS float* rs = (LAS float*)lds;
    const int q = tid & 255, half = tid >> 8, grp = __builtin_amdgcn_readfirstlane(q >> 6), base = 64 * half;
    const f32x4 gn = *(const f32x4*)(gain + 4 * q);
    for (int ch = bid; ch < T / 128; ch += G) {
        const int row0 = ch * 128, spos0 = row0 & (SEQ - 1), halo = spos0 ? 16 : 0;
        __syncthreads();
        if (tid < 128 + halo) { const int i = tid - halo; const f32x4* pp = (const f32x4*)(ssq + (size_t)(row0 + i) * 16);
            const f32x4 a0 = pp[0], a1 = pp[1], a2 = pp[2], a3 = pp[3];
            const float sa = ((a0.x + a0.y) + (a0.z + a0.w)) + ((a1.x + a1.y) + (a1.z + a1.w)) + ((a2.x + a2.y) + (a2.z + a2.w)) + ((a3.x + a3.y) + (a3.z + a3.w));
            rs[i + 16] = 1.0f / sqrtf(sa * (1.f / D) + RMS_EPS); }
        __syncthreads();
        const bf16_t* xc = X + (size_t)row0 * D + 4 * q; bf16_t* pout = P + (size_t)row0 * D + 4 * q;
        if (grp == 0) pool_pass_b<2>(xc, rs, gn, pout, base, -halo, spos0);
        else if (grp == 1) pool_pass_b<4>(xc, rs, gn, pout, base, -halo, spos0);
        else if (grp == 2) pool_pass_b<8>(xc, rs, gn, pout, base, -halo, spos0);
        else pool_pass_b<16>(xc, rs, gn, pout, base, -halo, spos0);
    }
}

__device__ __forceinline__ void router_phase(LAS unsigned char* lds, volatile LAS unsigned* MISC, const bf16_t* X, const float* gain, const float* wr, bf16_t* H,
                                             unsigned* gcnt, int* list, float* gsort, int* tokinfo, int G, int bid) {
    const int tid = opaque_tid(), lane = tid & 63, wid = __builtin_amdgcn_readfirstlane(tid >> 6);
    LAS float* wl = (LAS float*)lds;
    __syncthreads();
    for (int i = tid; i < D * NE / 4; i += 512) ((LAS f32x4*)wl)[i] = ((const f32x4*)wr)[i];
    f32x4 gn[4];
#pragma unroll
    for (int j = 0; j < 4; ++j) gn[j] = ((const f32x4*)gain)[lane + 64 * j];
    volatile LAS unsigned* lcnt = MISC + 32; volatile LAS unsigned* lbase = MISC + 40;
    for (int ch = bid; ch < T / 128; ch += G) {
        if (tid < 8) lcnt[tid] = 0u;
        __syncthreads();
        int me1 = 0, me2 = 0; float mg1 = 0.f, mg2 = 0.f;
        u32x2 vn[4];
        { const u32x2* xr = (const u32x2*)(X + (size_t)(ch * 128 + wid * 16) * D) + lane;
#pragma unroll
          for (int j = 0; j < 4; ++j) vn[j] = xr[64 * j]; }
#pragma unroll 1
        for (int i = 0; i < 16; ++i) {
            const int t = ch * 128 + wid * 16 + i;
            f32x4 v[4]; float s = 0.f;
#pragma unroll
            for (int j = 0; j < 4; ++j) v[j] = unpack4(vn[j]);
            { const u32x2* xr = (const u32x2*)(X + (size_t)(i < 15 ? t + 1 : t) * D) + lane;
#pragma unroll
              for (int j = 0; j < 4; ++j) vn[j] = xr[64 * j]; }
#pragma unroll
            for (int j = 0; j < 4; ++j) s += (v[j].x * v[j].x + v[j].y * v[j].y) + (v[j].z * v[j].z + v[j].w * v[j].w);
            const float rstd = 1.0f / sqrtf(wave_sum(s) * (1.f / D) + RMS_EPS);
            float lg[8];
#pragma unroll
            for (int e = 0; e < 8; ++e) lg[e] = 0.f;
            unsigned* o8 = (unsigned*)((unsigned char*)H + (size_t)t * D) + lane;
#pragma unroll
            for (int j = 0; j < 4; ++j) { const f32x4 y = v[j] * rstd * gn[j]; o8[64 * j] = pk4_fp8(y.x, y.y, y.z, y.w);
#pragma unroll
                for (int q = 0; q < 4; ++q) { const LAS f32x4* wp = (const LAS f32x4*)(wl + (size_t)(4 * lane + 256 * j + q) * 8); const f32x4 wa = wp[0], wb = wp[1]; const float yq = y[q];
                    lg[0] += yq * wa.x; lg[1] += yq * wa.y; lg[2] += yq * wa.z; lg[3] += yq * wa.w; lg[4] += yq * wb.x; lg[5] += yq * wb.y; lg[6] += yq * wb.z; lg[7] += yq * wb.w; } }
#pragma unroll
            for (int e = 0; e < 8; ++e) lg[e] = wave_sum(lg[e]);
            int e1 = 0; float v1 = lg[0];
#pragma unroll
            for (int e = 1; e < 8; ++e) if (lg[e] > v1) { v1 = lg[e]; e1 = e; }
            int e2 = -1; float v2 = -3.0e38f;
#pragma unroll
            for (int e = 0; e < 8; ++e) if (e != e1 && lg[e] > v2) { v2 = lg[e]; e2 = e; }
            const float g2 = 1.0f / (1.0f + __expf(v1 - v2)), g1 = 1.0f - g2;
            if (lane == i) { me1 = e1; me2 = e2; mg1 = g1; mg2 = g2; }
        }
        unsigned lp1 = 0, lp2 = 0;
        if (lane < 16) { lp1 = atomicAdd((unsigned*)(MISC + 32 + me1), 1u); lp2 = atomicAdd((unsigned*)(MISC + 32 + me2), 1u); }
        __syncthreads();
        if (tid < 8) lbase[tid] = __hip_atomic_fetch_add(gcnt + 64 * tid, lcnt[tid], RLX_AGENT);
        __syncthreads();
        if (lane < 16) { const int t = ch * 128 + wid * 16 + lane; const int p1 = (int)(lbase[me1] + lp1), p2 = (int)(lbase[me2] + lp2);
            list[me1 * T + p1] = t; gsort[me1 * T + p1] = mg1; list[me2 * T + p2] = t; gsort[me2 * T + p2] = mg2;
            tokinfo[2 * t] = (me1 << 20) | p1; tokinfo[2 * t + 1] = (me2 << 20) | p2; }
        __syncthreads();
    }
}
__device__ __forceinline__ void moe_tiles(volatile LAS int* tb, unsigned* gcnt) {
    __syncthreads();
    if (threadIdx.x == 0) { int a = 0;
        for (int e = 0; e < 8; ++e) { const int c = (int)__hip_atomic_load(gcnt + 64 * e, RLX_AGENT); tb[e] = a; tb[16 + e] = c; a += (c + 255) >> 8; }
        tb[8] = a; }
    __syncthreads();
}
__device__ __forceinline__ bool combine_row_load(volatile LAS int* tb, const bf16_t* X, const unsigned char* Y, const int* tokinfo, int t, u32x2 (&x)[4], unsigned (&a)[4], unsigned (&b)[4], int lane) {
    const int i0 = tokinfo[2 * t], i1 = tokinfo[2 * t + 1];
    const int s0 = tb[i0 >> 20] * 256 + (i0 & 0xFFFFF), s1 = tb[i1 >> 20] * 256 + (i1 & 0xFFFFF);
    const u32x2* xr = (const u32x2*)(X + (size_t)t * D) + lane; const unsigned* y0 = (const unsigned*)(Y + (size_t)s0 * D) + lane; const unsigned* y1 = (const unsigned*)(Y + (size_t)s1 * D) + lane;
#pragma unroll
    for (int j = 0; j < 4; ++j) { x[j] = __builtin_nontemporal_load(xr + 64 * j); a[j] = __builtin_nontemporal_load(y0 + 64 * j); b[j] = __builtin_nontemporal_load(y1 + 64 * j); }
    return (s0 >= 256 * 256) || (s1 >= 256 * 256);
}
__device__ __forceinline__ void combine_row_store(float* X, int t, const u32x2 (&xw)[4], const unsigned (&a)[4], const unsigned (&b)[4], const f32x4 (&gn)[4], int lane) {
    float s = 0.f; f32x4 x[4];
#pragma unroll
    for (int j = 0; j < 4; ++j) x[j] = unpack4(xw[j]);
#pragma unroll
    for (int j = 0; j < 4; ++j) {
        const f32x2 al = __builtin_amdgcn_cvt_pk_f32_fp8((int)a[j], false), ah = __builtin_amdgcn_cvt_pk_f32_fp8((int)a[j], true), bl = __builtin_amdgcn_cvt_pk_f32_fp8((int)b[j], false), bh = __builtin_amdgcn_cvt_pk_f32_fp8((int)b[j], true);
        x[j].x += (al.x + bl.x) * pg8::Y8_INV; x[j].y += (al.y + bl.y) * pg8::Y8_INV; x[j].z += (ah.x + bh.x) * pg8::Y8_INV; x[j].w += (ah.y + bh.y) * pg8::Y8_INV;
        s += (x[j].x * x[j].x + x[j].y * x[j].y) + (x[j].z * x[j].z + x[j].w * x[j].w); }
    const float rstd = 1.0f / sqrtf(wave_sum(s) * (1.f / D) + RMS_EPS);
    f32x4* xr = (f32x4*)(X + (size_t)t * D) + lane;
#pragma unroll
    for (int j = 0; j < 4; ++j) __builtin_nontemporal_store(x[j] * rstd * gn[j], xr + 64 * j);
}
constexpr int TAIL_SLOT0 = 256 * 256;
__device__ __forceinline__ void combine_main(volatile LAS int* tb, const bf16_t* Xb, float* X, const unsigned char* Y, const int* tokinfo, const float* gain, int nblk, int vbid) {
    const int tid = opaque_tid(), lane = tid & 63, gw = vbid * 8 + __builtin_amdgcn_readfirstlane(tid >> 6), ngw = nblk * 8;
    f32x4 gn[4];
#pragma unroll
    for (int j = 0; j < 4; ++j) gn[j] = ((const f32x4*)gain)[lane + 64 * j];
    for (int t = gw; t < T; t += 2 * ngw) {
        const int t1 = t + ngw; const bool two = t1 < T; const int tb1 = two ? t1 : t;
        u32x2 xa[4], xb[4]; unsigned aa[4], ab[4], ba[4], bb[4];
        const bool taila = combine_row_load(tb, Xb, Y, tokinfo, t, xa, aa, ab, lane);
        const bool tailb = combine_row_load(tb, Xb, Y, tokinfo, tb1, xb, ba, bb, lane);
        if (!taila) combine_row_store(X, t, xa, aa, ab, gn, lane);
        if (two && !tailb) combine_row_store(X, t1, xb, ba, bb, gn, lane);
    }
}
__device__ __forceinline__ void combine_tail(volatile LAS int* tb, const bf16_t* Xb, float* X, const unsigned char* Y, const int* tokinfo, const int* list, const float* gain, int G, int bid) {
    const int tid = opaque_tid(), lane = tid & 63, gw = bid * 8 + __builtin_amdgcn_readfirstlane(tid >> 6), ngw = G * 8;
    f32x4 gn[4];
#pragma unroll
    for (int j = 0; j < 4; ++j) gn[j] = ((const f32x4*)gain)[lane + 64 * j];
    const int send = tb[8] * 256;
    for (int sl = TAIL_SLOT0 + gw; sl < send; sl += ngw) {
        const int tile = sl >> 8; int e = 0;
#pragma unroll
        for (int j = 1; j < 8; ++j) e += (tile >= tb[j]) ? 1 : 0;
        const int pos = sl - tb[e] * 256;
        if (pos >= tb[16 + e]) continue;
        const int t = list[e * T + pos];
        const int i0 = tokinfo[2 * t], i1 = tokinfo[2 * t + 1];
        const int s0 = tb[i0 >> 20] * 256 + (i0 & 0xFFFFF), s1 = tb[i1 >> 20] * 256 + (i1 & 0xFFFFF), other = (s0 == sl) ? s1 : s0;
        if (other >= TAIL_SLOT0 && other > sl) continue;
        u32x2 xa[4]; unsigned aa[4], ab[4];
        (void)combine_row_load(tb, Xb, Y, tokinfo, t, xa, aa, ab, lane);
        combine_row_store(X, t, xa, aa, ab, gn, lane);
    }
}

constexpr int NPHASE = 14;
struct Args { const float* in[18]; float* out; unsigned char* ws; int ph_lo, ph_hi; };
__global__ void __launch_bounds__(512, 2) trunk_fwd(Args args) {
    extern __shared__ __attribute__((aligned(16))) unsigned char lds_raw[];
    LAS unsigned char* lds = (LAS unsigned char*)lds_raw;
    volatile LAS unsigned* MISC = (volatile LAS unsigned*)(lds + MISC_OFF);
    const int tid = threadIdx.x;
    const int G = gridDim.x, bid = blockIdx.x;
    asm volatile("s_setreg_imm32_b32 hwreg(HW_REG_MODE, 23, 1), 1" ::: "memory");
    unsigned char* ws = args.ws;
    unsigned* ctl = (unsigned*)(ws + WS_CTL);
    for (int u = tid; u < (LDS_BYTES - MISC_OFF) / 4; u += 512) MISC[u] = 0u;
    __syncthreads();
    if (tid < 18) { const unsigned long long p = (unsigned long long)args.in[tid]; MISC[64 + 2 * tid] = (unsigned)p; MISC[65 + 2 * tid] = (unsigned)(p >> 32); }
    __syncthreads();
#define INP(k) ((const float*)(((unsigned long long)(unsigned)__builtin_amdgcn_readfirstlane((int)MISC[65 + 2 * (k)]) << 32) | (unsigned long long)(unsigned)__builtin_amdgcn_readfirstlane((int)MISC[64 + 2 * (k)])))
#if MK_PER_PHASE
#define GRID_BAR() do { } while (0)
#else
    XcdBarrier bar = xcd_barrier_post(ctl + CW_BAR, MISC);
#define GRID_BAR() xcd_barrier(bar)
#endif
    const float* x_in = INP(0); float* out = args.out;
    bf16_t* Wqkv = (bf16_t*)(ws + WS_WQKV); bf16_t* Wo = (bf16_t*)(ws + WS_WO); bf16_t* Wgu = (bf16_t*)(ws + WS_WGU); bf16_t* Wd = (bf16_t*)(ws + WS_WD); bf16_t* Wp = (bf16_t*)(ws + WS_WP);
    unsigned char* Mgu = ws + WS_MGU; unsigned char* Md = ws + WS_MD;
    bf16_t* DLT = (bf16_t*)(ws + WS_B + 192 * MiB);
    bf16_t* X2B = (bf16_t*)(ws + WS_B + 256 * MiB);
    bf16_t* X3B = (bf16_t*)(ws + WS_B + 34 * MiB);
    float* RSTD0 = (float*)(ws + WS_B + 182 * MiB);
    float* SSQ = (float*)(ws + WS_B + 180 * MiB);
    bf16_t* HB = (bf16_t*)(ws + WS_HB); bf16_t* QKV = (bf16_t*)(ws + WS_B); bf16_t* ACT = (bf16_t*)(ws + WS_B); unsigned char* Yb = ws + WS_Y; unsigned char* MACT = ws + WS_MACT;
    int* list = (int*)(ws + WS_LIST); float* gsort = (float*)(ws + WS_GSORT); int* tokinfo = (int*)(ws + WS_TOKINFO);
    unsigned* gcnt = ctl + CW_CNT;
    volatile LAS int* tb = (volatile LAS int*)(MISC + 8);
    const int lo = args.ph_lo, hi = args.ph_hi;
#ifndef PHMASK
#define PHMASK 0xFFFFFFFFu
#endif
#define IN(k) ((((PHMASK) >> ((k) < 10 ? (k) : (10 + (((k) - 10) & 1)))) & 1u) && lo <= (k) && (k) < hi)
#define SEAM(k) do { if (IN(k) && IN((k) + 1)) GRID_BAR(); } while (0)

    for (int rep = 0; rep < REPS(0); ++rep) { if (rep) GRID_BAR(); if (IN(0)) {
        { const ConvPtrs CP{INP(2), INP(4), INP(6), INP(7), INP(8), INP(10), INP(14), INP(15), INP(16), Wqkv, Wo, Wgu, Wd, Wp, Mgu, Md, INP(1), INP(5)};
          conv_run(lds, CP, 0, CONV_L0, G, bid); }
        xcopy_phase(x_in, DLT, RSTD0, G, bid);
    }
    }
    SEAM(0);
    for (int rep = 0; rep < REPS(1); ++rep) { if (rep) GRID_BAR(); if (IN(1)) {
        const int g1 = ((G & 3) == 0 && G >= 64) ? (G * 3) / 4 : G;
        if (bid < g1) {
            pg8::DenseOrder S{(const char*)DLT, (const char*)Wqkv, 2 * D, 2 * D, T / 256, QKVW / 256, g1, bid, 0}; pg8::EpiQKV E{QKV, RSTD0};
            pg8::gemm_phase<pg8::EpiQKV, pg8::DenseOrder, false, true, true, false>(lds, S, E, 2 * D, 2 * D, 2 * D);
        } else {
            const ConvPtrs CP{INP(2), INP(4), INP(6), INP(7), INP(8), INP(10), INP(14), INP(15), INP(16), Wqkv, Wo, Wgu, Wd, Wp, Mgu, Md, INP(1), INP(5)};
            conv_run(lds, CP, CONV_L0, CONV_P1, G - g1, bid - g1);
        }
    }
    }
    SEAM(1);
    for (int rep = 0; rep < REPS(2); ++rep) { if (rep) GRID_BAR(); if (IN(2)) {
        const bool p1conv = ((G & 3) == 0 && G >= 64);
        const int nconv = p1conv ? (G * CFG_NCONV2) / 32 : (G * 3) / 8;
        const int conv_lo = p1conv ? CONV_P1 : CONV_L0;
        const int CONV_X = conv_lo + (int)((long)(CONV_ALL - conv_lo) * (p1conv ? CFG_X2 : 27) / 32);
        const ConvPtrs CP{INP(2), INP(4), INP(6), INP(7), INP(8), INP(10), INP(14), INP(15), INP(16), Wqkv, Wo, Wgu, Wd, Wp, Mgu, Md, INP(1), INP(5)};
        if (bid < nconv) conv_run(lds, CP, conv_lo, CONV_X, nconv, bid);
        else { attn_phase(lds, QKV, HB, INP(3), G - nconv, bid - nconv); __syncthreads(); conv_run(lds, CP, CONV_X, CONV_ALL, G - nconv, bid - nconv); } }
    }
    SEAM(2);
    for (int rep = 0; rep < REPS(3); ++rep) { if (rep) GRID_BAR(); if (IN(3)) {
        pg8::DenseOrder S{(const char*)HB, (const char*)Wo, 2 * D, 2 * D, T / 256, D / 256, G, bid, 0}; pg8::EpiResF32 E{DLT, DLT, nullptr, SSQ};
        pg8::gemm_phase<pg8::EpiResF32, pg8::DenseOrder, false, true, true, false>(lds, S, E, 2 * D, 2 * D, 2 * D);
    }
    }
    SEAM(3);
    for (int rep = 0; rep < REPS(5); ++rep) { if (rep) GRID_BAR(); if (IN(5)) {
        pg8::DenseOrder S{(const char*)DLT, (const char*)Wgu, 2 * D, 2 * D, T / 256, 2 * DFF / 256, G, bid, 0}; pg8::EpiSwiGLU<false> E{(unsigned char*)ACT, 2 * DFF, 0, SSQ, nullptr};
        { constexpr int RT_OFF = pg8::IDX_OFF + 2048, RT_MAX = (MISC_OFF - RT_OFF) / 1024;
          LAS float* rt = (LAS float*)(lds + RT_OFF); pg8::Unit u; int nu = 0;
          while (S.next(nu, u)) ++nu;
          if (nu <= RT_MAX) {
              if (tid < 256) for (int i = 0; i < nu; ++i) { (void)S.next(i, u); const f32x4* pp = (const f32x4*)(SSQ + (size_t)(u.pm * 256 + tid) * 16); const f32x4 a0 = pp[0], a1 = pp[1], a2 = pp[2], a3 = pp[3];
                  const float sa = ((a0.x + a0.y) + (a0.z + a0.w)) + ((a1.x + a1.y) + (a1.z + a1.w)) + ((a2.x + a2.y) + (a2.z + a2.w)) + ((a3.x + a3.y) + (a3.z + a3.w));
                  rt[i * 256 + tid] = 1.0f / sqrtf(sa * (1.f / D) + RMS_EPS); }
              E.rtab = rt; }
          __syncthreads(); }
        pg8::gemm_phase<pg8::EpiSwiGLU<false>, pg8::DenseOrder, false, true, true, false>(lds, S, E, 2 * D, 2 * D, 2 * D);
    }
    }
    SEAM(5);
    for (int rep = 0; rep < REPS(6); ++rep) { if (rep) GRID_BAR();
    if (IN(6)) {
        pg8::DenseOrder S{(const char*)ACT, (const char*)Wd, 2 * DFF, 2 * DFF, T / 256, D / 256, G, bid, 0}; pg8::EpiResF32 E{DLT, X2B, nullptr, SSQ};
        pg8::gemm_phase<pg8::EpiResF32, pg8::DenseOrder, false, true, true, false>(lds, S, E, 2 * DFF, 2 * DFF, 2 * DFF);
    }
    }
    SEAM(6);
    for (int rep = 0; rep < REPS(7); ++rep) { if (rep) GRID_BAR(); if (IN(7)) pool_phase(lds, X2B, SSQ, INP(9), HB, G, bid);
    }
    SEAM(7);
    if (IN(8)) {
        pg8::DenseOrder S{(const char*)HB, (const char*)Wp, 2 * D, 512, T / 256, 4, G, bid, 1}; pg8::EpiResF32 E{X2B, X3B, INP(11), nullptr};
        pg8::gemm_phase<pg8::EpiResF32, pg8::DenseOrder, false, true, true, false>(lds, S, E, 512, 2 * D, 512);
    }
    SEAM(8);
    if (IN(9)) router_phase(lds, MISC, X3B, INP(12), INP(13), HB, gcnt, list, gsort, tokinfo, G, bid);
    SEAM(9);
    if (hi > 10) moe_tiles(tb, gcnt);
    {
        const int Gt = tb[8], Gm = Gt < 256 ? Gt : 256, ntail = Gt - Gm;
        for (int rep = 0; rep < REPS(10); ++rep) { if (rep) GRID_BAR();
        if (IN(10) && Gt > 0) {
            pg8::MoeOrder S{(const char*)HB, (const char*)Mgu, D, D, Gt, 2 * DFE / 256, G, bid, 0, 0, (size_t)2 * DFE * D, tb, list, 1}; pg8::EpiSwiGLU<true> E{MACT, DFE, 0};
            pg8::gemm_phase<pg8::EpiSwiGLU<true>, pg8::MoeOrder, true, true, true, true>(lds, S, E, D, D, D);
        }
        }
        SEAM(10);
        for (int rep = 0; rep < REPS(11); ++rep) { if (rep) GRID_BAR();
        if (IN(11) && Gm > 0) {
            pg8::MoeOrder S{(const char*)MACT, (const char*)Md, DFE, DFE, Gm, D / 256, G, bid, 0, 0, (size_t)D * DFE, tb, list, 0}; pg8::EpiMoeDown E{Yb, gsort, tb};
            pg8::gemm_phase<pg8::EpiMoeDown, pg8::MoeOrder, false, true, true, true>(lds, S, E, DFE, DFE, DFE);
        }
        }
        SEAM(11);
        if (IN(12)) {
            const int nbusy = 4 * ntail;
            if (ntail > 0) {
                pg8::MoeOrder S{(const char*)MACT, (const char*)Md, DFE, DFE, ntail, D / 256, G, bid, 0, 256, (size_t)D * DFE, tb, list, 0}; pg8::EpiMoeDown E{Yb, gsort, tb};
                pg8::gemm_phase<pg8::EpiMoeDown, pg8::MoeOrder, false, true, true, true>(lds, S, E, DFE, DFE, DFE);
            }
            if (bid >= nbusy && G > nbusy) combine_main(tb, X3B, out, Yb, tokinfo, INP(17), G - nbusy, bid - nbusy);
            else if (G <= nbusy) combine_main(tb, X3B, out, Yb, tokinfo, INP(17), G, bid);
        }
        SEAM(12);
        if (IN(13)) combine_tail(tb, X3B, out, Yb, tokinfo, list, INP(17), G, bid);
    }
#undef IN
#undef SEAM
#undef INP
}

extern "C" void kernel_launch(void* const* d_in, const int* in_sizes, int n_in, void* d_out, int out_size, void* d_ws, size_t ws_size, hipStream_t stream) {
    static int grid = 0;
    if (grid == 0) {
        if (n_in != 18 || in_sizes[0] != T * D || out_size != T * D || ws_size < WS_END) { fprintf(stderr, "kernel_launch: unexpected shapes / workspace (%d inputs, ws %zu < %zu)\n", n_in, ws_size, (size_t)WS_END); grid = -1; return; }
        int dev = 0, cus = 0, per_cu = 0;
        if (hipGetDevice(&dev) != hipSuccess || hipDeviceGetAttribute(&cus, hipDeviceAttributeMultiprocessorCount, dev) != hipSuccess) { grid = -1; return; }
        if (hipFuncSetAttribute((const void*)trunk_fwd, hipFuncAttributeMaxDynamicSharedMemorySize, LDS_BYTES) != hipSuccess) { fprintf(stderr, "kernel_launch: hipFuncSetAttribute failed\n"); grid = -1; return; }
        if (hipOccupancyMaxActiveBlocksPerMultiprocessor(&per_cu, (const void*)trunk_fwd, 512, LDS_BYTES) != hipSuccess || per_cu < 1) fprintf(stderr, "kernel_launch: occupancy query reports %d\n", per_cu);
        (void)hipGetLastError();
        grid = cus;
    }
    if (grid < 0) return;
    if (hipMemsetAsync((char*)d_ws + WS_CTL, 0, CTL_ZERO_BYTES, stream) != hipSuccess) return;
    Args a{};
    for (int i = 0; i < 18; ++i) a.in[i] = (const float*)d_in[i];
    a.out = (float*)d_out; a.ws = (unsigned char*)d_ws;
#if MK_PER_PHASE
    for (int ph = 0; ph < NPHASE; ++ph) { a.ph_lo = ph; a.ph_hi = ph + 1; hipLaunchKernelGGL(trunk_fwd, dim3(grid), dim3(512), LDS_BYTES, stream, a); }
#else
    a.ph_lo = 0; a.ph_hi = NPHASE;
    hipLaunchKernelGGL(trunk_fwd, dim3(grid), dim3(512), LDS_BYTES, stream, a);
#endif
}
```
